# Optimizing an MI355X kernel written in HIP

```python
import jax, jax.numpy as jnp
from jax import lax
import numpy as np

D_MODEL = 2048
BATCH = 2
SEQ = 4096
DEPTH = 1
DEC_BATCH = 16
DEC_SEQ = 16
PAST_LEN = 1024

CHUNK = 64
EPS = 1e-6
GLA_HEADS = 4
GLA_DK = D_MODEL // 2
GLA_DV = D_MODEL
GLA_HK = GLA_DK // GLA_HEADS
GLA_HV = GLA_DV // GLA_HEADS
GLA_GATE_RANK = 16
GLA_GATE_TAU = 16.0
MLA_HEADS = 16
MLA_Q_LORA = 512
MLA_KV_LORA = 512
MLA_NOPE = 128
MLA_ROPE = 64
MLA_VDIM = 128
MLA_SCALE = (MLA_NOPE + MLA_ROPE) ** -0.5
ROPE_THETA = 10000.0
Q_BLOCK = 128
D_FF = 5632
CONV_W = 3
IN_SIZES = (GLA_DK, GLA_DK, GLA_DV, GLA_GATE_RANK, GLA_DV,
            MLA_Q_LORA, MLA_KV_LORA, MLA_ROPE, D_MODEL, D_MODEL)
IN_COLS = 2 * GLA_DK + 2 * GLA_DV + GLA_GATE_RANK + MLA_Q_LORA + MLA_KV_LORA + MLA_ROPE + 2 * D_MODEL

kernel_name = "hybrid_gla_mla_convffn_stream_step"


def rms_norm(x, g):
    xf = x.astype(jnp.float32)
    y = xf * lax.rsqrt(jnp.mean(xf * xf, axis=-1, keepdims=True) + EPS)
    return (y * g.astype(jnp.float32)).astype(x.dtype)


def split_cols(z, sizes):
    offs = [int(o) for o in np.cumsum(sizes)[:-1]]
    return jnp.split(z, offs, axis=-1)


def rope(x, pos):
    half = MLA_ROPE // 2
    inv = ROPE_THETA ** (-jnp.arange(half, dtype=jnp.float32) * 2.0 / MLA_ROPE)
    ang = pos.astype(jnp.float32)[:, None] * inv[None, :]
    shape = (1, pos.shape[0]) + (1,) * (x.ndim - 3) + (half,)
    cos = jnp.cos(ang).reshape(shape)
    sin = jnp.sin(ang).reshape(shape)
    xf = x.astype(jnp.float32)
    x1, x2 = xf[..., :half], xf[..., half:]
    return jnp.concatenate([x1 * cos - x2 * sin, x2 * cos + x1 * sin], axis=-1).astype(x.dtype)


def gla_scan(q, k, v, log_a, S0, block):
    B, T = q.shape[:2]
    n = T // block

    def to_blocks(t):
        return t.reshape((B, n, block) + t.shape[2:]).swapaxes(0, 1)

    causal = jnp.tril(jnp.ones((block, block), dtype=bool))

    def step(S, inp):
        qc, kc, vc, ac = inp
        b = jnp.cumsum(ac, axis=1)
        diff = b[:, :, None] - b[:, None, :]
        decay = jnp.exp(jnp.where(causal[None, :, :, None, None], diff, -jnp.inf))
        A = jnp.einsum('bthd,bshd,btshd->bhts', qc, kc, decay)
        o = (jnp.einsum('bhts,bshv->bthv', A, vc)
             + jnp.einsum('bthd,bhdv->bthv', qc * jnp.exp(b), S))
        bl = b[:, -1]
        S_new = (jnp.exp(bl)[..., None] * S
                 + jnp.einsum('bshd,bshv->bhdv', kc * jnp.exp(bl[:, None] - b), vc))
        return S_new, o

    S_fin, o = lax.scan(step, S0, (to_blocks(q), to_blocks(k), to_blocks(v), to_blocks(log_a)))
    o = o.swapaxes(0, 1).reshape((B, T) + v.shape[2:])
    return o, S_fin


def mla_project(q_lat, kv_lat, kpe_raw, pos, lp):
    B, T = q_lat.shape[:2]
    q = (rms_norm(q_lat, lp["mla_g_qlat"]) @ lp["mla_w_uq"]).reshape(B, T, MLA_HEADS, MLA_NOPE + MLA_ROPE)
    q_nope = rms_norm(q[..., :MLA_NOPE], lp["mla_g_q"])
    q_pe = rope(rms_norm(q[..., MLA_NOPE:], lp["mla_g_qpe"]), pos)
    ckv = rms_norm(kv_lat, lp["mla_g_kvlat"])
    kpe = rope(rms_norm(kpe_raw, lp["mla_g_kpe"]), pos)
    return q_nope, q_pe, ckv, kpe


def mla_expand(ckv, lp):
    B, T = ckv.shape[:2]
    kv = (ckv @ lp["mla_w_ukv"]).reshape(B, T, MLA_HEADS, MLA_NOPE + MLA_VDIM)
    return rms_norm(kv[..., :MLA_NOPE], lp["mla_g_k"]), kv[..., MLA_NOPE:]


def mla_attend(q_nope, q_pe, k_nope, kpe, v, mask):
    s = (jnp.einsum('bqhd,bkhd->bhqk', q_nope, k_nope)
         + jnp.einsum('bqhr,bkr->bhqk', q_pe, kpe))
    s = s.astype(jnp.float32) * MLA_SCALE
    if mask is not None:
        s = jnp.where(mask, s, -jnp.inf)
    p = jax.nn.softmax(s, axis=-1)
    return jnp.einsum('bhqk,bkhv->bqhv', p.astype(v.dtype), v)


def mla_prompt_attention(q_nope, q_pe, k_nope, kpe, v):
    B, T = q_nope.shape[:2]
    nb = T // Q_BLOCK
    kchunk = jnp.arange(T) // CHUNK

    def blk(args):
        qn, qp, i = args
        qchunk = (i * Q_BLOCK + jnp.arange(Q_BLOCK)) // CHUNK
        mask = (kchunk[None, :] <= qchunk[:, None])[None, None]
        return mla_attend(qn, qp, k_nope, kpe, v, mask)

    qn_b = q_nope.reshape(B, nb, Q_BLOCK, MLA_HEADS, MLA_NOPE).swapaxes(0, 1)
    qp_b = q_pe.reshape(B, nb, Q_BLOCK, MLA_HEADS, MLA_ROPE).swapaxes(0, 1)
    out = lax.map(blk, (qn_b, qp_b, jnp.arange(nb)))
    return out.swapaxes(0, 1).reshape(B, T, MLA_HEADS * MLA_VDIM)


def trunk_layer(x, pos, gla_S0, gla_block, ckv_past, kpe_past, conv_hist, lp):
    B, T, _ = x.shape
    f32 = jnp.float32
    h = rms_norm(x, lp["g_norm1"])
    (a_q, a_k, a_v, a_lr, a_r, m_q, m_kv, m_kpe, gate_a, gate_b) = split_cols(h @ lp["w_in"], IN_SIZES)
    qh = a_q.reshape(B, T, GLA_HEADS, GLA_HK).astype(f32) * (GLA_HK ** -0.5)
    kh = a_k.reshape(B, T, GLA_HEADS, GLA_HK).astype(f32)
    vh = a_v.reshape(B, T, GLA_HEADS, GLA_HV).astype(f32)
    log_a = (jax.nn.log_sigmoid((a_lr @ lp["gla_w_gate2"] + lp["gla_b_gate"]).astype(f32))
             / GLA_GATE_TAU).reshape(B, T, GLA_HEADS, GLA_HK)
    o, S_new = gla_scan(qh, kh, vh, log_a, gla_S0.astype(f32), gla_block)
    o = rms_norm(o.astype(x.dtype), lp["gla_g_out"]).reshape(B, T, GLA_DV) * jax.nn.silu(a_r)
    y_a = o @ lp["w_br_gla"]
    q_nope, q_pe, ckv, kpe = mla_project(m_q, m_kv, m_kpe, pos, lp)
    if ckv_past is None:
        k_nope, v = mla_expand(ckv, lp)
        att = mla_prompt_attention(q_nope, q_pe, k_nope, kpe, v)
    else:
        ckv_all = jnp.concatenate([ckv_past.astype(ckv.dtype), ckv], axis=1)
        kpe_all = jnp.concatenate([kpe_past.astype(kpe.dtype), kpe], axis=1)
        k_nope, v = mla_expand(ckv_all, lp)
        att = mla_attend(q_nope, q_pe, k_nope, kpe_all, v, None).reshape(B, T, MLA_HEADS * MLA_VDIM)
    y_b = att @ lp["w_br_mla"]
    x = x + (jax.nn.sigmoid(gate_a) * y_a + jax.nn.sigmoid(gate_b) * y_b) @ lp["w_out"]
    h2 = rms_norm(x, lp["g_norm2"])
    a, gt = jnp.split(h2 @ lp["ffn_w_up"], [D_FF], axis=-1)
    a_ext = jnp.concatenate([conv_hist.astype(a.dtype), a], axis=1)
    cw = lp["ffn_conv_w"]
    c = lp["ffn_conv_b"] + cw[CONV_W - 1] * a_ext[:, CONV_W - 1:]
    for j in range(CONV_W - 1):
        c = c + cw[j] * a_ext[:, j:j + T]
    x = x + (jax.nn.gelu(c, approximate=False) * gt) @ lp["ffn_w_down"]
    return x, S_new.astype(x.dtype), ckv, kpe, a_ext[:, -(CONV_W - 1):]


def setup_inputs(seed: int = 0) -> dict:
    key = jax.random.key(seed)
    ks = jax.random.split(key, 32)
    f32 = jnp.float32

    def nrm(k, shape, scale):
        return jax.random.normal(k, shape, f32) * scale

    def gain(k, n):
        return 1.0 + nrm(k, (DEPTH, n), 0.01)

    return {
        "x_prompt": nrm(ks[0], (BATCH, SEQ, D_MODEL), 1.0),
        "x_sample": nrm(ks[1], (DEC_BATCH, DEC_SEQ, D_MODEL), 1.0),
        "state_gla": nrm(ks[2], (DEPTH, DEC_BATCH, GLA_HEADS, GLA_HK, GLA_HV), 0.5),
        "cache_mla_ckv": nrm(ks[3], (DEPTH, DEC_BATCH, PAST_LEN, MLA_KV_LORA), 1.0),
        "cache_mla_kpe": nrm(ks[4], (DEPTH, DEC_BATCH, PAST_LEN, MLA_ROPE), 1.0),
        "cache_ffn_conv": nrm(ks[5], (DEPTH, DEC_BATCH, CONV_W - 1, D_FF), 1.0),
        "w_in": nrm(ks[6], (DEPTH, D_MODEL, IN_COLS), D_MODEL ** -0.5),
        "g_norm1": gain(ks[7], D_MODEL),
        "gla_w_gate2": nrm(ks[8], (DEPTH, GLA_GATE_RANK, GLA_DK), GLA_GATE_RANK ** -0.5),
        "gla_b_gate": nrm(ks[9], (DEPTH, GLA_DK), 0.1),
        "gla_g_out": gain(ks[10], GLA_HV),
        "w_br_gla": nrm(ks[11], (DEPTH, GLA_DV, D_MODEL), GLA_DV ** -0.5),
        "mla_g_qlat": gain(ks[12], MLA_Q_LORA),
        "mla_w_uq": nrm(ks[13], (DEPTH, MLA_Q_LORA, MLA_HEADS * (MLA_NOPE + MLA_ROPE)), MLA_Q_LORA ** -0.5),
        "mla_g_kvlat": gain(ks[14], MLA_KV_LORA),
        "mla_w_ukv": nrm(ks[15], (DEPTH, MLA_KV_LORA, MLA_HEADS * (MLA_NOPE + MLA_VDIM)), MLA_KV_LORA ** -0.5),
        "mla_g_q": gain(ks[16], MLA_NOPE),
        "mla_g_k": gain(ks[17], MLA_NOPE),
        "mla_g_qpe": gain(ks[18], MLA_ROPE),
        "mla_g_kpe": gain(ks[19], MLA_ROPE),
        "w_br_mla": nrm(ks[20], (DEPTH, MLA_HEADS * MLA_VDIM, D_MODEL), (MLA_HEADS * MLA_VDIM) ** -0.5),
        "w_out": nrm(ks[21], (DEPTH, D_MODEL, D_MODEL), D_MODEL ** -0.5),
        "g_norm2": gain(ks[22], D_MODEL),
        "ffn_w_up": nrm(ks[23], (DEPTH, D_MODEL, 2 * D_FF), D_MODEL ** -0.5),
        "ffn_conv_w": nrm(ks[24], (DEPTH, CONV_W, D_FF), CONV_W ** -0.5),
        "ffn_conv_b": nrm(ks[25], (DEPTH, D_FF), 0.01),
        "ffn_w_down": nrm(ks[26], (DEPTH, D_FF, D_MODEL), D_FF ** -0.5),
    }


def reference(x_prompt, x_sample, state_gla, cache_mla_ckv, cache_mla_kpe, cache_ffn_conv,
              w_in, g_norm1, gla_w_gate2, gla_b_gate, gla_g_out, w_br_gla,
              mla_g_qlat, mla_w_uq, mla_g_kvlat, mla_w_ukv, mla_g_q, mla_g_k, mla_g_qpe, mla_g_kpe,
              w_br_mla, w_out, g_norm2, ffn_w_up, ffn_conv_w, ffn_conv_b, ffn_w_down):
    B, T = x_prompt.shape[:2]
    DB, DT = x_sample.shape[:2]
    past = cache_mla_ckv.shape[2]
    pos_p = jnp.arange(T)
    pos_s = past + jnp.arange(DT)
    xp, xs = x_prompt, x_sample
    sp_l, ss_l, cp_l, cs_l, kp_l, ks_l, fp_l, fs_l = [], [], [], [], [], [], [], []
    for l in range(DEPTH):
        lp = {
            "w_in": w_in[l], "g_norm1": g_norm1[l],
            "gla_w_gate2": gla_w_gate2[l], "gla_b_gate": gla_b_gate[l], "gla_g_out": gla_g_out[l],
            "w_br_gla": w_br_gla[l],
            "mla_g_qlat": mla_g_qlat[l], "mla_w_uq": mla_w_uq[l], "mla_g_kvlat": mla_g_kvlat[l],
            "mla_w_ukv": mla_w_ukv[l], "mla_g_q": mla_g_q[l], "mla_g_k": mla_g_k[l],
            "mla_g_qpe": mla_g_qpe[l], "mla_g_kpe": mla_g_kpe[l], "w_br_mla": w_br_mla[l],
            "w_out": w_out[l], "g_norm2": g_norm2[l],
            "ffn_w_up": ffn_w_up[l], "ffn_conv_w": ffn_conv_w[l], "ffn_conv_b": ffn_conv_b[l],
            "ffn_w_down": ffn_w_down[l],
        }
        S0 = jnp.zeros((B, GLA_HEADS, GLA_HK, GLA_HV), jnp.float32)
        hist0 = jnp.zeros((B, CONV_W - 1, D_FF), xp.dtype)
        xp, sp, cp, kp, fp = trunk_layer(xp, pos_p, S0, CHUNK, None, None, hist0, lp)
        xs, ss, cs, kss, fs = trunk_layer(xs, pos_s, state_gla[l], DT, cache_mla_ckv[l],
                                          cache_mla_kpe[l], cache_ffn_conv[l], lp)
        sp_l.append(sp); ss_l.append(ss); cp_l.append(cp); cs_l.append(cs)
        kp_l.append(kp); ks_l.append(kss); fp_l.append(fp); fs_l.append(fs)
    return (xp, xs,
            jnp.stack(sp_l, 0), jnp.stack(ss_l, 0),
            jnp.stack(cp_l, 0), jnp.stack(cs_l, 0),
            jnp.stack(kp_l, 0), jnp.stack(ks_l, 0),
            jnp.stack(fp_l, 0), jnp.stack(fs_l, 0))
```

```cpp
#include <hip/hip_runtime.h>
#include <hip/hip_cooperative_groups.h>
#include <cstdio>
#include <cstdint>
#include <cmath>
namespace cg = cooperative_groups;

namespace pg8 {
#define PG8_LAS __attribute__((address_space(3)))
typedef unsigned short bf16_t;
typedef short bf16x8 __attribute__((ext_vector_type(8)));
typedef float f32x4 __attribute__((ext_vector_type(4)));
typedef unsigned u32x4 __attribute__((ext_vector_type(4)));
constexpr int BM = 256, BK = 64, HALF = 128, HTB = HALF * BK * 2  , STAGE_BYTES = 8 * HTB, NXCD = 8, WGM = 8;

__host__ __device__ __forceinline__ int lds_byte(int r, int c) { const int st = (r >> 4) * 2 + (c >> 5), rr = r & 15, cc = c & 31, ob = rr * 64 + cc * 2; return st * 1024 + (ob ^ (((ob >> 9) & 1) << 5)); }
__host__ __device__ __forceinline__ void stage_rc(int b, int& R, int& C) { const int st = b / 1024, sb = b % 1024, swz = sb ^ (((sb >> 9) & 1) << 5); R = (st >> 1) * 16 + swz / 64; C = (st & 1) * 32 + (swz % 64) / 2; }
__host__ __device__ __forceinline__ int perm32(int rho) { const int n = rho >> 4, i = rho & 15; return 8 * (i >> 2) + 4 * n + (i & 3); }

struct Unit { int pm, pn, kofs; };
struct Gemm { const bf16_t* A; const bf16_t* Bt; int M, N, K, lda, ldb; };

struct StaticOrder {
    int nM, nN, nwg, G, c;
    __host__ __device__ void init(int M, int N, int G_, int c_) { nM = M / BM; nN = N / BM; nwg = nM * nN; G = G_; c = c_; }
    __host__ __device__ bool next(int i, Unit& u) const {
        const long L = (long)i * G + c; if (L >= nwg) return false;
        int wgid = (int)L; { const int q = nwg / NXCD, r = nwg % NXCD, xcd = wgid % NXCD, off = wgid / NXCD; wgid = (xcd < r ? xcd * (q + 1) : r * (q + 1) + (xcd - r) * q) + off; }
        const int nig = WGM * nN, gid = wgid / nig, fm = gid * WGM, gsz = (nM - fm) < WGM ? (nM - fm) : WGM;
        u.pm = fm + ((wgid % nig) % gsz); u.pn = (wgid % nig) / gsz; u.kofs = 0; return true;
    }
    __device__ __forceinline__ void a_ready(const Unit&) const {}
    __device__ __forceinline__ void done(const Unit&) const {}
};
struct SplitOrder {
    int pm, nN, nsplit, ksz, G, c;
    __device__ __forceinline__ bool next(int i, Unit& u) const { const int L = i * G + c; if (L >= nN * nsplit) return false; u.pm = pm; u.pn = L % nN; u.kofs = (L / nN) * ksz; return true; }
    __device__ __forceinline__ void a_ready(const Unit&) const {}
    __device__ __forceinline__ void done(const Unit&) const {}
};
__device__ __forceinline__ unsigned cvt_pk_bf16(float lo, float hi) { unsigned r; asm volatile("v_cvt_pk_bf16_f32 %0, %1, %2" : "=v"(r) : "v"(lo), "v"(hi)); return r; }

template <class Epi, class Sched, bool ALIGN_EPI = false, bool SP2 = false>
__device__ __forceinline__ void gemm_phase(PG8_LAS unsigned char* lds, const Gemm g, const Sched& S, const Epi& E) {
    int tid_ = threadIdx.x; asm volatile("" : "+v"(tid_)); const int tid = tid_, wid = __builtin_amdgcn_readfirstlane(tid >> 6), lane = tid & 63, wr = wid >> 2, wc = wid & 3, fr = lane & 15, fq = lane >> 4;
    const int K = g.K, nt = K / BK;
    unsigned voffA[2], voffB[2];
#pragma unroll
    for (int i = 0; i < 2; ++i) { int R, C; stage_rc(tid * 16 + i * 8192, R, C); const int Rb = Epi::PERM ? ((R & ~31) + perm32(R & 31)) : R;
        voffA[i] = (unsigned)(R * g.lda + C) * 2u; voffB[i] = (unsigned)(Rb * g.ldb + C) * 2u; }
    const size_t kstep = (size_t)(BK * 2);
    const size_t hstepA = (size_t)HALF * g.lda * 2, hstepB = (size_t)HALF * g.ldb * 2;
    const size_t tstepA = 2 * hstepA, tstepB = 2 * hstepB;
    const unsigned ldsw = (unsigned)wid * 1024u;
    const int aoff = lds_byte(wr * 64 + fr, fq * 8), boff = lds_byte(wc * 32 + fr, fq * 8);
#define PG8_SA(b, h) (((b) * 2 + (h)) * HTB)
#define PG8_SB(b, h) ((4 + (b) * 2 + (h)) * HTB)
#define PG8_STAGE(bufoff, gbase, voff) do { _Pragma("unroll") for (int _i = 0; _i < 2; ++_i) \
        __builtin_amdgcn_global_load_lds((const unsigned*)((const char*)(gbase) + (voff)[_i]), (PG8_LAS unsigned*)(lds + (bufoff) + ldsw + _i * 8192), 16, 0, 0); } while (0)
#define PG8_LDA(dst, b, h) do { _Pragma("unroll") for (int m = 0; m < 4; ++m) _Pragma("unroll") for (int k = 0; k < 2; ++k) dst[m][k] = *(const PG8_LAS bf16x8*)(lds + PG8_SA(b, h) + aoff + m * 2048 + k * 1024); } while (0)
#define PG8_LDB(dst, b, h) do { _Pragma("unroll") for (int n = 0; n < 2; ++n) _Pragma("unroll") for (int k = 0; k < 2; ++k) dst[n][k] = *(const PG8_LAS bf16x8*)(lds + PG8_SB(b, h) + boff + n * 2048 + k * 1024); } while (0)
#define PG8_MMA(ai, bj, At, Bt) do { __builtin_amdgcn_s_setprio(1); _Pragma("unroll") for (int m = 0; m < 4; ++m) _Pragma("unroll") for (int n = 0; n < 2; ++n) _Pragma("unroll") for (int k = 0; k < 2; ++k) \
        acc[ai][bj][m][n] = __builtin_amdgcn_mfma_f32_16x16x32_bf16(Bt[n][k], At[m][k], acc[ai][bj][m][n], 0, 0, 0); __builtin_amdgcn_s_setprio(0); } while (0)
#define PG8_WAIT_V(n) asm volatile("s_waitcnt vmcnt(" #n ")" ::: "memory")
#define PG8_WAIT_L(n) asm volatile("s_waitcnt lgkmcnt(" #n ")" ::: "memory")
#define PG8_BAR __builtin_amdgcn_s_barrier()
#define PG8_SCHED __builtin_amdgcn_sched_barrier(0)
    Unit cur, nxt; int ui = 0;
    if (!S.next(0, cur)) return;
    f32x4 acc[2][2][4][2];
#pragma unroll
    for (int a = 0; a < 2; ++a)
#pragma unroll
        for (int b = 0; b < 2; ++b)
#pragma unroll
            for (int m = 0; m < 4; ++m)
#pragma unroll
                for (int n = 0; n < 2; ++n) acc[a][b][m][n] = (f32x4){0.f, 0.f, 0.f, 0.f};
    bf16x8 At[4][2], B0[2][2], B1[2][2];
    const char* cA = (const char*)g.A + (size_t)cur.pm * tstepA + (size_t)cur.kofs * 2; const char* cB = (const char*)g.Bt + (size_t)cur.pn * tstepB + (size_t)cur.kofs * 2;
    S.a_ready(cur);
    if constexpr (SP2) {
        PG8_STAGE(PG8_SB(0, 0), cB, voffB); PG8_STAGE(PG8_SB(0, 1), cB + hstepB, voffB); PG8_STAGE(PG8_SA(0, 0), cA, voffA); PG8_STAGE(PG8_SA(0, 1), cA + hstepA, voffA);
        if (wr == 1) PG8_BAR;
        PG8_WAIT_V(2); PG8_BAR;
        PG8_STAGE(PG8_SB(1, 0), cB + kstep, voffB); PG8_STAGE(PG8_SA(1, 0), cA + kstep, voffA); PG8_STAGE(PG8_SB(1, 1), cB + hstepB + kstep, voffB);
        PG8_WAIT_V(6); PG8_BAR;
    } else {
        PG8_STAGE(PG8_SB(0, 0), cB, voffB); PG8_STAGE(PG8_SA(0, 0), cA, voffA); PG8_STAGE(PG8_SB(0, 1), cB + hstepB, voffB); PG8_STAGE(PG8_SA(0, 1), cA + hstepA, voffA);
        if (wr == 1) PG8_BAR;
        PG8_WAIT_V(4); PG8_BAR;
        PG8_STAGE(PG8_SB(1, 0), cB + kstep, voffB); PG8_STAGE(PG8_SA(1, 0), cA + kstep, voffA); PG8_STAGE(PG8_SB(1, 1), cB + hstepB + kstep, voffB);
        PG8_WAIT_V(6); PG8_BAR;
    }
    for (;;) {
        const bool has_next = S.next(ui + 1, nxt);
        const char* nA = has_next ? (const char*)g.A + (size_t)nxt.pm * tstepA + (size_t)nxt.kofs * 2 : cA; const char* nB = has_next ? (const char*)g.Bt + (size_t)nxt.pn * tstepB + (size_t)nxt.kofs * 2 : cB;
        for (int t = 0; t < nt; t += 2) {
            if constexpr (Epi::HAS_MID) { if (t == (nt >> 1)) E.mid(acc, cur, wr, wc, fr, fq); }
            const bool last = (t == nt - 2);
            const char* a1 = cA + (size_t)(t + 1) * kstep;
            const char* a2 = last ? nA : cA + (size_t)(t + 2) * kstep; const char* b2 = last ? nB : cB + (size_t)(t + 2) * kstep;
            const char* a3 = a2 + kstep; const char* b3 = b2 + kstep;
            if (last && has_next) S.a_ready(nxt);
            if constexpr (SP2) {
            PG8_LDB(B0, 0, 0); PG8_LDB(B1, 0, 1); PG8_SCHED; PG8_LDA(At, 0, 0); PG8_STAGE(PG8_SA(1, 1), a1 + hstepA, voffA);
            PG8_WAIT_V(8); PG8_WAIT_L(0); PG8_BAR; PG8_MMA(0, 0, At, B0); PG8_MMA(0, 1, At, B1); PG8_BAR; PG8_SCHED;
            PG8_LDA(At, 0, 1); PG8_STAGE(PG8_SB(0, 0), b2, voffB); PG8_STAGE(PG8_SB(0, 1), b2 + hstepB, voffB); PG8_STAGE(PG8_SA(0, 0), a2, voffA);
            PG8_WAIT_V(8); PG8_WAIT_L(0); PG8_BAR; PG8_MMA(1, 0, At, B0); PG8_MMA(1, 1, At, B1); PG8_BAR; PG8_SCHED;
            PG8_LDB(B0, 1, 0); PG8_LDB(B1, 1, 1); PG8_SCHED; PG8_LDA(At, 1, 0); PG8_STAGE(PG8_SA(0, 1), a2 + hstepA, voffA);
            PG8_WAIT_V(8); PG8_WAIT_L(0); PG8_BAR; PG8_MMA(0, 0, At, B0); PG8_MMA(0, 1, At, B1); PG8_BAR; PG8_SCHED;
            PG8_LDA(At, 1, 1); PG8_STAGE(PG8_SB(1, 0), b3, voffB); PG8_STAGE(PG8_SB(1, 1), b3 + hstepB, voffB); PG8_STAGE(PG8_SA(1, 0), a3, voffA);
            PG8_WAIT_V(8); PG8_WAIT_L(0); PG8_BAR; PG8_MMA(1, 0, At, B0); PG8_MMA(1, 1, At, B1); PG8_BAR; PG8_SCHED;
            } else {
            PG8_LDB(B0, 0, 0); PG8_SCHED; PG8_LDA(At, 0, 0); PG8_STAGE(PG8_SA(1, 1), a1 + hstepA, voffA);
            PG8_WAIT_L(8); PG8_BAR; PG8_WAIT_L(0); PG8_MMA(0, 0, At, B0); PG8_BAR; PG8_SCHED;
            PG8_LDB(B1, 0, 1); PG8_STAGE(PG8_SB(0, 0), b2, voffB);
            PG8_BAR; PG8_WAIT_L(0); PG8_MMA(0, 1, At, B1); PG8_BAR;
            PG8_LDA(At, 0, 1); PG8_STAGE(PG8_SA(0, 0), a2, voffA);
            PG8_BAR; PG8_WAIT_L(0); PG8_MMA(1, 0, At, B0); PG8_BAR; PG8_SCHED;
            PG8_STAGE(PG8_SB(0, 1), b2 + hstepB, voffB);
            PG8_WAIT_V(6); PG8_BAR; PG8_MMA(1, 1, At, B1); PG8_BAR;
            PG8_LDB(B0, 1, 0); PG8_SCHED; PG8_LDA(At, 1, 0); PG8_STAGE(PG8_SA(0, 1), a2 + hstepA, voffA);
            PG8_WAIT_L(8); PG8_BAR; PG8_WAIT_L(0); PG8_MMA(0, 0, At, B0); PG8_BAR; PG8_SCHED;
            PG8_LDB(B1, 1, 1); PG8_STAGE(PG8_SB(1, 0), b3, voffB);
            PG8_BAR; PG8_WAIT_L(0); PG8_MMA(0, 1, At, B1); PG8_BAR;
            PG8_LDA(At, 1, 1); PG8_STAGE(PG8_SA(1, 0), a3, voffA);
            PG8_BAR; PG8_WAIT_L(0); PG8_MMA(1, 0, At, B0); PG8_BAR; PG8_SCHED;
            PG8_STAGE(PG8_SB(1, 1), b3 + hstepB, voffB);
            PG8_WAIT_V(6); PG8_BAR; PG8_MMA(1, 1, At, B1); PG8_BAR;
            }
        }
        if constexpr (ALIGN_EPI) { if (wr == 0) PG8_BAR; }
        if constexpr (!Epi::AFTER_DRAIN) { E(acc, cur, wr, wc, fr, fq); S.done(cur); }
        if (!has_next) break;
#pragma unroll
        for (int a = 0; a < 2; ++a)
#pragma unroll
            for (int b = 0; b < 2; ++b)
#pragma unroll
                for (int m = 0; m < 4; ++m)
#pragma unroll
                    for (int n = 0; n < 2; ++n) acc[a][b][m][n] = (f32x4){0.f, 0.f, 0.f, 0.f};
        cur = nxt; cA = nA; cB = nB; ++ui;
        if constexpr (ALIGN_EPI) { if (wr == 1) PG8_BAR; }
    }
    PG8_WAIT_V(0);
    if constexpr (!ALIGN_EPI) { if (wr == 0) PG8_BAR; }
    PG8_BAR;
    if constexpr (Epi::AFTER_DRAIN) { E.fused(acc, cur, wr, wc, fr, fq, lds, wid, lane); S.done(cur); }
#undef PG8_SA
#undef PG8_SB
#undef PG8_STAGE
#undef PG8_LDA
#undef PG8_LDB
#undef PG8_MMA
#undef PG8_WAIT_V
#undef PG8_WAIT_L
#undef PG8_BAR
#undef PG8_SCHED
}
}

#define LAS __attribute__((address_space(3)))
typedef unsigned short bf16_t;
typedef short bf16x8 __attribute__((ext_vector_type(8)));
typedef float f32x4 __attribute__((ext_vector_type(4)));
typedef float f32x16 __attribute__((ext_vector_type(16)));
typedef unsigned u32x4 __attribute__((ext_vector_type(4)));
typedef unsigned u32x2 __attribute__((ext_vector_type(2)));

constexpr int DM = 2048, TP = 4096, MP = 8192, DBS = 16, DTS = 16, MA = 8448;
constexpr int PAST = 1024, KSS = 1040;
constexpr int MKV = MP + DBS * KSS;
constexpr int MKVP = MKV + 64;
constexpr int DFF = 5632, NIN = 11520, NCH = 144;
constexpr float EPS = 1e-6f;
constexpr int LDS_BYTES = 163840;
constexpr int XS_OFF = 131072;

constexpr size_t WS_SUMSQ = 0, WS_CTR = 40960, WS_EBL = 65536, WS_ROPE = 1048576;
constexpr size_t WS_WUQ = 2097152, WS_WUKV = 5242880, WS_CKVALL = 9437184, WS_KPEALL = 34930688;
constexpr size_t WS_E = 38117376;
constexpr size_t WS_ZV = 72720384, WS_ZR = 107323392, WS_ZGA = 141926400, WS_ZGB = 176529408;
constexpr size_t WS_D = 211132416;
constexpr size_t WS_ZQ = 258318336, WS_ZK = 275619840, WS_ZMQ = 292921344, WS_ZMKV = 301572096, WS_ZMISC = 310222848;
constexpr size_t WS_ZKT = 314548224, WS_AF = 331849728;
constexpr size_t WS_KN = 228433920, WS_VT = 330407936;
constexpr size_t WS_WBR = WS_ZV, WS_WOUT = WS_ZV + 16777216, WS_MB = WS_ZR;
constexpr size_t WS_TA = WS_KN;
constexpr size_t WS_WUP = 368561664, WS_WDOWN = 414699008, WS_END = 437767680;
constexpr size_t WS_U = WS_ZV, WS_G = 263036928, WS_SIDE = WS_ZV, WS_PART = WS_ZV + 33554432;
constexpr int VTP = MKVP;
constexpr size_t O_Y = 0, O_ST = 17301504, O_CKV = 26738688, O_KPE = 31064064, O_FCP = 31604736, O_FCS = 31627264, O_END = 31807488;

struct Args { const float* in[27]; float* out; unsigned char* ws; };

__device__ __forceinline__ unsigned pk2(float lo, float hi) { return pg8::cvt_pk_bf16(lo, hi); }
__device__ __forceinline__ float bf2f(unsigned short b) { return __uint_as_float((unsigned)b << 16); }
__device__ __forceinline__ float bflo(unsigned w) { return __uint_as_float(w << 16); }
__device__ __forceinline__ float bfhi(unsigned w) { return __uint_as_float(w & 0xffff0000u); }
__device__ __forceinline__ float wave_sum(float v) {
#pragma unroll
    for (int o = 1; o < 64; o <<= 1) v += __shfl_xor(v, o);
    return v;
}
#define LDS_WAIT() asm volatile("s_waitcnt lgkmcnt(0)" ::: "memory")
__device__ __forceinline__ void unpack8(const u32x4 w, float (&x)[8]) { x[0] = bflo(w.x); x[1] = bfhi(w.x); x[2] = bflo(w.y); x[3] = bfhi(w.y); x[4] = bflo(w.z); x[5] = bfhi(w.z); x[6] = bflo(w.w); x[7] = bfhi(w.w); }

struct ScId { __device__ __forceinline__ int operator()(int d) const { return d; } };
struct ScIn { __device__ __forceinline__ int operator()(int d) const {
    if (d < 4096) return d;
    if (d < 6144) return 4112 + (d - 4096);
    if (d < 8192) return 7248 + (d - 6144);
    if (d < 10240) return 9296 + (d - 8192);
    if (d < 10752) return 6160 + (d - 10240);
    if (d < 11264) return 6672 + (d - 10752);
    if (d < 11328) return 7184 + (d - 11264);
    if (d < 11344) return 4096 + (d - 11328);
    return -1; } };
struct ScUq { __device__ __forceinline__ int operator()(int d) const {
    if (d < 2048) return (d >> 7) * 192 + (d & 127);
    d -= 2048; const int h = d >> 6, p = d & 63; return h * 192 + 128 + (p & 1) * 32 + (p >> 1); } };
struct ScUkv { __device__ __forceinline__ int operator()(int d) const {
    if (d < 2048) return (d >> 7) * 256 + (d & 127);
    d -= 2048; return (d >> 7) * 256 + 128 + (d & 127); } };

struct ScUp { __device__ __forceinline__ int operator()(int d) const { const int pn = d >> 8, c = d & 255; return c < 128 ? pn * 128 + c : 5632 + pn * 128 + (c - 128); } };
template <class SC>
__device__ __forceinline__ void transpose_item(const float* __restrict__ W, int Nsrc, bf16_t* __restrict__ WT, int ldt, int koff, LAS float* scr, int kb, int nb, int lane, const float* __restrict__ kscale, SC sc) {
    const int k0 = 64 * kb, n0 = 32 * nb;
    const int scl = sc(n0 + (lane & 31));
#pragma unroll 8
    for (int i = 0; i < 32; ++i) { const int kk = 2 * i + (lane >> 5); float v = scl >= 0 ? __builtin_nontemporal_load(W + (size_t)(k0 + kk) * Nsrc + scl) : 0.f; if (kscale) v *= kscale[k0 + kk]; scr[kk * 33 + (lane & 31)] = v; }
    LDS_WAIT();
    const int c = lane & 7;
#pragma unroll
    for (int j = 0; j < 4; ++j) { const int n = (lane >> 3) + 8 * j; const LAS float* s = scr + (8 * c) * 33 + n;
        u32x4 o; o.x = pk2(s[0 * 33], s[1 * 33]); o.y = pk2(s[2 * 33], s[3 * 33]); o.z = pk2(s[4 * 33], s[5 * 33]); o.w = pk2(s[6 * 33], s[7 * 33]);
        *(u32x4*)(WT + (size_t)(n0 + n) * ldt + koff + k0 + 8 * c) = o; }
    LDS_WAIT();
}
template <class SC>
__device__ __forceinline__ void transpose_item_q(const float* __restrict__ W, int Nsrc, bf16_t* __restrict__ WT, int ldt, int koff, int kb, int nb, int lane, const float* __restrict__ kscale, SC sc) {
    const int nq = lane & 7, ko = lane >> 3, k0 = 64 * kb + 8 * ko, n0 = 32 * nb + 4 * nq;
    const int scl = sc(n0);
    f32x4 v[8];
#pragma unroll
    for (int i = 0; i < 8; ++i) v[i] = scl >= 0 ? __builtin_nontemporal_load((const f32x4*)(W + (size_t)(k0 + i) * Nsrc + scl)) : (f32x4){0.f, 0.f, 0.f, 0.f};
    if (kscale) { const f32x4 s0 = *(const f32x4*)(kscale + k0), s1 = *(const f32x4*)(kscale + k0 + 4);
#pragma unroll
        for (int i = 0; i < 4; ++i) { v[i] = v[i] * s0[i]; v[4 + i] = v[4 + i] * s1[i]; } }
#pragma unroll
    for (int j = 0; j < 4; ++j) { u32x4 o; o.x = pk2(v[0][j], v[1][j]); o.y = pk2(v[2][j], v[3][j]); o.z = pk2(v[4][j], v[5][j]); o.w = pk2(v[6][j], v[7][j]);
        *(u32x4*)(WT + (size_t)(n0 + j) * ldt + koff + k0) = o; }
}
template <class SC>
__device__ __forceinline__ void transpose_matrix_q(const float* W, int K, int Nsrc, int Ndst, bf16_t* WT, int ldt, int koff, const float* kscale, SC sc, int gw, int NGW, int lane) {
    const int nblk = Ndst / 32, nit = (K / 64) * nblk;
    for (int it = gw; it < nit; it += NGW) transpose_item_q(W, Nsrc, WT, ldt, koff, it / nblk, it % nblk, lane, kscale, sc);
}
template <class SC>
__device__ __forceinline__ void transpose_matrix(const float* W, int K, int Nsrc, int Ndst, bf16_t* WT, int ldt, int koff, const float* kscale, SC sc, LAS float* scr, int gw, int NGW, int lane) {
    const int nblk = Ndst / 32, nit = (K / 64) * nblk;
    for (int it = gw; it < nit; it += NGW) transpose_item(W, Nsrc, WT, ldt, koff, scr, it / nblk, it % nblk, lane, kscale, sc);
}

struct EpiZ {
    static constexpr bool PERM = true, AFTER_DRAIN = false, HAS_MID = false;
    unsigned char* ws;
    __device__ __forceinline__ void operator()(const pg8::f32x4 (&acc)[2][2][4][2], const pg8::Unit& u, int wr, int wc, int fr, int fq) const {
        const int pn = u.pn; size_t off; int ld, c0;
        if (pn < 4) { off = WS_ZQ; ld = 1024; c0 = pn * 256; }
        else if (pn < 8) { off = WS_ZK; ld = 1024; c0 = (pn - 4) * 256; }
        else if (pn < 16) { off = WS_ZV; ld = 2048; c0 = (pn - 8) * 256; }
        else if (pn < 24) { off = WS_ZR; ld = 2048; c0 = (pn - 16) * 256; }
        else if (pn < 32) { off = WS_ZGA; ld = 2048; c0 = (pn - 24) * 256; }
        else if (pn < 40) { off = WS_ZGB; ld = 2048; c0 = (pn - 32) * 256; }
        else if (pn < 42) { off = WS_ZMQ; ld = 512; c0 = (pn - 40) * 256; }
        else if (pn < 44) { off = WS_ZMKV; ld = 512; c0 = (pn - 42) * 256; }
        else { off = WS_ZMISC; ld = 256; c0 = 0; }
        bf16_t* base = (bf16_t*)(ws + off);
        const int row0 = u.pm * 256 + wr * 64 + fr, col0 = c0 + wc * 32 + 8 * fq;
#pragma unroll
        for (int ai = 0; ai < 2; ++ai)
#pragma unroll
            for (int m = 0; m < 4; ++m) { bf16_t* rowp = base + (size_t)(row0 + ai * 128 + m * 16) * ld + col0;
#pragma unroll
                for (int bj = 0; bj < 2; ++bj) { const pg8::f32x4 v0 = acc[ai][bj][m][0], v1 = acc[ai][bj][m][1];
                    u32x4 w; w.x = pk2(v0[0], v0[1]); w.y = pk2(v0[2], v0[3]); w.z = pk2(v1[0], v1[1]); w.w = pk2(v1[2], v1[3]);
                    *(u32x4*)(rowp + bj * 128) = w; } }
    }
};

__device__ __forceinline__ int kvrow(int m) { return m < MP ? m : MP + ((m - MP) >> 4) * KSS + PAST + ((m - MP) & 15); }
__device__ __forceinline__ int tokpos(int m) { return m < MP ? (m & (TP - 1)) : PAST + ((m - MP) & 15); }

__device__ __forceinline__ void phase0(const Args& a, LAS unsigned char* lds, int G) {
    int tid_ = threadIdx.x; asm volatile("" : "+v"(tid_)); const int tid = tid_, lane = tid & 63, wave = __builtin_amdgcn_readfirstlane(tid >> 6);
    const int gw = blockIdx.x * 8 + wave, NGW = G * 8;
    LAS float* scr = (LAS float*)(lds + wave * 16384);
    unsigned char* ws = a.ws;
    transpose_matrix_q(a.in[6], 2048, 11344, NIN, (bf16_t*)(ws + WS_D), 2048, 0, nullptr, ScIn(), gw, NGW, lane);
    transpose_matrix(a.in[13], 512, 3072, 3072, (bf16_t*)(ws + WS_WUQ), 512, 0, nullptr, ScUq(), scr, gw, NGW, lane);
    transpose_matrix_q(a.in[15], 512, 4096, 4096, (bf16_t*)(ws + WS_WUKV), 512, 0, nullptr, ScUkv(), gw, NGW, lane);
    {
        const float* g1 = a.in[7]; bf16_t* H1 = (bf16_t*)(ws + WS_E);
        for (int m = gw; m < MA; m += NGW) {
            const float* xr = m < MP ? a.in[0] + (size_t)m * DM : a.in[1] + (size_t)(m - MP) * DM;
            f32x4 v[8]; float ss = 0.f;
#pragma unroll
            for (int j = 0; j < 8; ++j) { v[j] = __builtin_nontemporal_load((const f32x4*)(xr + 4 * lane + 256 * j)); ss += (v[j].x * v[j].x + v[j].y * v[j].y) + (v[j].z * v[j].z + v[j].w * v[j].w); }
            ss = wave_sum(ss); const float rstd = 1.0f / sqrtf(ss * (1.f / 2048.f) + EPS);
            bf16_t* o = H1 + (size_t)m * DM;
#pragma unroll
            for (int j = 0; j < 8; ++j) { const f32x4 g = *(const f32x4*)(g1 + 4 * lane + 256 * j);
                u32x2 w; w.x = pk2(v[j].x * rstd * g.x, v[j].y * rstd * g.y); w.y = pk2(v[j].z * rstd * g.z, v[j].w * rstd * g.w);
                *(u32x2*)(o + 4 * lane + 256 * j) = w; }
        }
    }
    {
        bf16_t* CK = (bf16_t*)(ws + WS_CKVALL); bf16_t* KP = (bf16_t*)(ws + WS_KPEALL);
        for (int r = gw; r < DBS * PAST; r += NGW) {
            const int db = r >> 10, p = r & 1023; const size_t row = (size_t)MP + db * KSS + p;
            const float* src = a.in[3] + (size_t)r * 512 + 8 * lane;
            const f32x4 x0 = __builtin_nontemporal_load((const f32x4*)src), x1 = __builtin_nontemporal_load((const f32x4*)(src + 4));
            u32x4 w; w.x = pk2(x0.x, x0.y); w.y = pk2(x0.z, x0.w); w.z = pk2(x1.x, x1.y); w.w = pk2(x1.z, x1.w);
            *(u32x4*)(CK + row * 512 + 8 * lane) = w;
            if (lane < 32) { const float* ks = a.in[4] + (size_t)r * 64; *(unsigned*)(KP + row * 64 + 2 * lane) = pk2(ks[lane], ks[32 + lane]); }
        }
    }
    {
        float* RT = (float*)(ws + WS_ROPE); const int gt = blockIdx.x * 512 + tid, NT = G * 512;
        for (int idx = gt; idx < 4096 * 32; idx += NT) { const int pos = idx >> 5, i = idx & 31;
            const float inv = exp2f(-(float)(2 * i) * (1.f / 64.f) * 13.287712379549449f);
            const float ang = (float)pos * inv; double rev = (double)ang * 0.15915494309189535; rev -= floor(rev); const float rv = (float)rev;
            RT[2 * idx] = __builtin_amdgcn_cosf(rv); RT[2 * idx + 1] = __builtin_amdgcn_sinf(rv); }
        float* SS = (float*)(ws + WS_SUMSQ);
        for (int i = gt; i < MA; i += NT) SS[i] = 0.f;
    }
}

__device__ __forceinline__ int crow(int r, int hi) { return (r & 3) + 8 * (r >> 2) + 4 * hi; }

__device__ __forceinline__ void phase2(const Args& a, LAS unsigned char* lds, int G) {
    int tid_ = threadIdx.x; asm volatile("" : "+v"(tid_)); const int tid = tid_, lane = tid & 63, wave = __builtin_amdgcn_readfirstlane(tid >> 6);
    unsigned char* ws = a.ws;
    bf16_t* ZQ = (bf16_t*)(ws + WS_ZQ); bf16_t* ZK = (bf16_t*)(ws + WS_ZK); bf16_t* ZMISC = (bf16_t*)(ws + WS_ZMISC);
    {
        LAS bf16_t* Qs = (LAS bf16_t*)lds; LAS bf16_t* Ks = (LAS bf16_t*)(lds + 66560);
        const float* w2 = a.in[8]; const float* bgp = a.in[9]; float* EBL = (float*)(ws + WS_EBL);
        bf16_t* ZKT = (bf16_t*)(ws + WS_ZKT); bf16_t* AF = (bf16_t*)(ws + WS_AF);
        for (int it = blockIdx.x; it < NCH * 2; it += G) {
            const int ci = it >> 1, half = it & 1, nrows = ci < 128 ? 64 : 16, row0 = ci < 128 ? ci * 64 : MP + (ci - 128) * 16;
            const int d = half * 512 + tid;
            float w2c[16];
#pragma unroll
            for (int r = 0; r < 16; ++r) w2c[r] = w2[r * 1024 + d];
            const float bg = bgp[d]; float b = 0.f;
#pragma unroll 8
            for (int t = 0; t < 64; ++t) {
                float qv = 0.f, kv = 0.f;
                if (t < nrows) {
                    const bf16_t* zm = ZMISC + (size_t)(row0 + t) * 256 + 64;
                    const u32x4 l0 = *(const u32x4*)zm, l1 = *(const u32x4*)(zm + 8);
                    float x = bg;
                    x += bflo(l0.x) * w2c[0] + bfhi(l0.x) * w2c[1] + bflo(l0.y) * w2c[2] + bfhi(l0.y) * w2c[3];
                    x += bflo(l0.z) * w2c[4] + bfhi(l0.z) * w2c[5] + bflo(l0.w) * w2c[6] + bfhi(l0.w) * w2c[7];
                    x += bflo(l1.x) * w2c[8] + bfhi(l1.x) * w2c[9] + bflo(l1.y) * w2c[10] + bfhi(l1.y) * w2c[11];
                    x += bflo(l1.z) * w2c[12] + bfhi(l1.z) * w2c[13] + bflo(l1.w) * w2c[14] + bfhi(l1.w) * w2c[15];
                    const float xc = fminf(fmaxf(x, -60.f), 60.f);
                    const float la2 = -__builtin_amdgcn_logf(1.0f + __builtin_amdgcn_exp2f(-xc * 1.4426950408889634f)) * 0.0625f;
                    b += la2; const float e = __builtin_amdgcn_exp2f(b), ei = __builtin_amdgcn_exp2f(-b);
                    const size_t o = (size_t)(row0 + t) * 1024 + d;
                    qv = bf2f(ZQ[o]) * 0.0625f * e; kv = bf2f(ZK[o]) * ei;
                }
                Qs[t * 520 + tid] = (bf16_t)(pk2(qv, 0.f) & 0xffffu); Ks[t * 520 + tid] = (bf16_t)(pk2(kv, 0.f) & 0xffffu);
            }
            EBL[ci * 1024 + d] = __builtin_amdgcn_exp2f(b);
            __syncthreads();
            if (wave < 6) {
                const int hh = wave / 3, tl = wave - 3 * hh, sb = tl == 2 ? 1 : 0, tb = tl == 0 ? 0 : 1, l32 = lane & 31, hi = lane >> 5;
                f32x16 acc = {};
                const LAS bf16_t* kp = Ks + (32 * sb + l32) * 520 + hh * 256 + 8 * hi; const LAS bf16_t* qp = Qs + (32 * tb + l32) * 520 + hh * 256 + 8 * hi;
#pragma unroll
                for (int ks = 0; ks < 16; ++ks) { const bf16x8 af = *(const LAS bf16x8*)(kp + 16 * ks), bfr = *(const LAS bf16x8*)(qp + 16 * ks);
                    acc = __builtin_amdgcn_mfma_f32_32x32x16_bf16(af, bfr, acc, 0, 0, 0); }
                unsigned w[8];
#pragma unroll
                for (int r = 0; r < 16; r += 2) { float v0 = acc[r], v1 = acc[r + 1];
                    if (tl != 1) { if (crow(r, hi) > l32) v0 = 0.f; if (crow(r + 1, hi) > l32) v1 = 0.f; }
                    w[r >> 1] = pk2(v0, v1); }
                bf16_t* dst = AF + ((size_t)((ci * 4 + 2 * half + hh) * 3 + tl) * 64 + lane) * 16;
                *(u32x4*)dst = (u32x4){w[0], w[1], w[2], w[3]}; *(u32x4*)(dst + 8) = (u32x4){w[4], w[5], w[6], w[7]};
            }
#pragma unroll
            for (int i = 0; i < 8; ++i) { const int c = tid + 512 * i, row = c >> 6, cc = c & 63, gi = cc >> 1, hi = cc & 1;
                if (row < nrows) { const LAS bf16_t* s = Qs + row * 520 + 16 * gi + 4 * hi;
                    const u32x2 lo = *(const LAS u32x2*)s, hi2 = *(const LAS u32x2*)(s + 8);
                    *(u32x4*)(ZQ + (size_t)(row0 + row) * 1024 + half * 512 + 8 * cc) = (u32x4){lo.x, lo.y, hi2.x, hi2.y}; } }
            for (int tg = 0; tg < nrows / 8; ++tg) { unsigned w[4];
#pragma unroll
                for (int j = 0; j < 4; ++j) w[j] = (unsigned)Ks[(8 * tg + 2 * j) * 520 + tid] | ((unsigned)Ks[(8 * tg + 2 * j + 1) * 520 + tid] << 16);
                *(u32x4*)(ZKT + (size_t)d * MA + row0 + 8 * tg) = (u32x4){w[0], w[1], w[2], w[3]}; }
            __syncthreads();
        }
    }
    {
        const int gw = blockIdx.x * 8 + wave, NGW = G * 8;
        bf16_t* ZMQ = (bf16_t*)(ws + WS_ZMQ); bf16_t* ZMKV = (bf16_t*)(ws + WS_ZMKV);
        bf16_t* CK = (bf16_t*)(ws + WS_CKVALL); bf16_t* KP = (bf16_t*)(ws + WS_KPEALL);
        const float* gq = a.in[12]; const float* gkv = a.in[14]; const float* gkp = a.in[19]; const float* RT = (const float*)(ws + WS_ROPE);
        float* CKO = a.out + O_CKV; float* KPO = a.out + O_KPE;
        for (int m = gw; m < MA; m += NGW) {
            {
                bf16_t* p = ZMQ + (size_t)m * 512 + 8 * lane; const u32x4 w = __builtin_nontemporal_load((const u32x4*)p);
                float x[8] = {bflo(w.x), bfhi(w.x), bflo(w.y), bfhi(w.y), bflo(w.z), bfhi(w.z), bflo(w.w), bfhi(w.w)};
                float ss = 0.f;
#pragma unroll
                for (int j = 0; j < 8; ++j) ss += x[j] * x[j];
                ss = wave_sum(ss); const float rstd = 1.0f / sqrtf(ss * (1.f / 512.f) + EPS);
                const f32x4 g0 = *(const f32x4*)(gq + 8 * lane), g1 = *(const f32x4*)(gq + 8 * lane + 4);
                u32x4 o; o.x = pk2(x[0] * rstd * g0.x, x[1] * rstd * g0.y); o.y = pk2(x[2] * rstd * g0.z, x[3] * rstd * g0.w);
                o.z = pk2(x[4] * rstd * g1.x, x[5] * rstd * g1.y); o.w = pk2(x[6] * rstd * g1.z, x[7] * rstd * g1.w);
                *(u32x4*)p = o;
            }
            const size_t kr = (size_t)kvrow(m);
            {
                const u32x4 w = __builtin_nontemporal_load((const u32x4*)(ZMKV + (size_t)m * 512 + 8 * lane));
                float x[8] = {bflo(w.x), bfhi(w.x), bflo(w.y), bfhi(w.y), bflo(w.z), bfhi(w.z), bflo(w.w), bfhi(w.w)};
                float ss = 0.f;
#pragma unroll
                for (int j = 0; j < 8; ++j) ss += x[j] * x[j];
                ss = wave_sum(ss); const float rstd = 1.0f / sqrtf(ss * (1.f / 512.f) + EPS);
                const f32x4 g0 = *(const f32x4*)(gkv + 8 * lane), g1 = *(const f32x4*)(gkv + 8 * lane + 4);
                const f32x4 y0 = {x[0] * rstd * g0.x, x[1] * rstd * g0.y, x[2] * rstd * g0.z, x[3] * rstd * g0.w};
                const f32x4 y1 = {x[4] * rstd * g1.x, x[5] * rstd * g1.y, x[6] * rstd * g1.z, x[7] * rstd * g1.w};
                *(f32x4*)(CKO + (size_t)m * 512 + 8 * lane) = y0; *(f32x4*)(CKO + (size_t)m * 512 + 8 * lane + 4) = y1;
                u32x4 o; o.x = pk2(y0.x, y0.y); o.y = pk2(y0.z, y0.w); o.z = pk2(y1.x, y1.y); o.w = pk2(y1.z, y1.w);
                *(u32x4*)(CK + kr * 512 + 8 * lane) = o;
            }
            {
                const bf16_t* zm = ZMISC + (size_t)m * 256; const int i = lane & 31;
                const float x1 = bf2f(zm[i]), x2 = bf2f(zm[32 + i]);
                float ss = lane < 32 ? x1 * x1 + x2 * x2 : 0.f; ss = wave_sum(ss); const float rstd = 1.0f / sqrtf(ss * (1.f / 64.f) + EPS);
                if (lane < 32) { const float y1 = x1 * rstd * gkp[i], y2 = x2 * rstd * gkp[32 + i];
                    const float c = RT[(tokpos(m) * 32 + i) * 2], s = RT[(tokpos(m) * 32 + i) * 2 + 1];
                    const float o1 = y1 * c - y2 * s, o2 = y2 * c + y1 * s;
                    KPO[(size_t)m * 64 + i] = o1; KPO[(size_t)m * 64 + 32 + i] = o2;
                    *(unsigned*)(KP + kr * 64 + 2 * i) = pk2(o1, o2); }
            }
        }
    }
}

struct EpiHead {
    static constexpr bool PERM = true, AFTER_DRAIN = false, HAS_MID = false;
    bf16_t* O0; int ld0; const float* gain0; int nsplit; bf16_t* O1; int ld1; const float* gain1; const float* RT; LAS float* xs; float oscale;
    __device__ __forceinline__ void operator()(const pg8::f32x4 (&acc)[2][2][4][2], const pg8::Unit& u, int wr, int wc, int fr, int fq) const {
#pragma unroll
        for (int ai = 0; ai < 2; ++ai)
#pragma unroll
            for (int m = 0; m < 4; ++m)
#pragma unroll
                for (int bj = 0; bj < 2; ++bj) { const pg8::f32x4 v0 = acc[ai][bj][m][0], v1 = acc[ai][bj][m][1];
                    float s = (v0[0] * v0[0] + v0[1] * v0[1]) + (v0[2] * v0[2] + v0[3] * v0[3]) + (v1[0] * v1[0] + v1[1] * v1[1]) + (v1[2] * v1[2] + v1[3] * v1[3]);
                    s += __shfl_xor(s, 16); s += __shfl_xor(s, 32);
                    if (fq == 0) xs[((ai * 128 + wr * 64 + m * 16 + fr) * 2 + bj) * 4 + wc] = s; __builtin_amdgcn_sched_barrier(0); }
        asm volatile("s_waitcnt lgkmcnt(0)" ::: "memory"); __builtin_amdgcn_s_barrier(); asm volatile("" ::: "memory");
        const bool rope = u.pn >= nsplit;
        int cl = wc * 32 + 8 * fq;
        asm volatile("" : "+v"(cl));
        if (!rope) {
            const pg8::f32x4 g0 = *(const pg8::f32x4*)(gain0 + cl), g1 = *(const pg8::f32x4*)(gain0 + cl + 4);
#pragma unroll
            for (int ai = 0; ai < 2; ++ai)
#pragma unroll
                for (int m = 0; m < 4; ++m) { const int rl = ai * 128 + wr * 64 + m * 16 + fr; bf16_t* rowp = O0 + (size_t)(u.pm * 256 + rl) * ld0 + u.pn * 256 + cl;
#pragma unroll
                    for (int bj = 0; bj < 2; ++bj) { const pg8::f32x4 p = *(const LAS pg8::f32x4*)(xs + (rl * 2 + bj) * 4);
                        const float rstd = oscale / sqrtf(((p[0] + p[1]) + (p[2] + p[3])) * (1.f / 128.f) + EPS);
                        const pg8::f32x4 v0 = acc[ai][bj][m][0] * rstd * g0, v1 = acc[ai][bj][m][1] * rstd * g1;
                        u32x4 w; w.x = pk2(v0[0], v0[1]); w.y = pk2(v0[2], v0[3]); w.z = pk2(v1[0], v1[1]); w.w = pk2(v1[2], v1[3]);
                        *(u32x4*)(rowp + bj * 128) = w; } __builtin_amdgcn_sched_barrier(0); }
        } else {
            const int p0 = cl & 63, i0 = p0 >> 1;
            float ga[8];
#pragma unroll
            for (int j = 0; j < 8; ++j) ga[j] = gain1[((p0 + j) & 1) * 32 + ((p0 + j) >> 1)];
#pragma unroll
            for (int ai = 0; ai < 2; ++ai)
#pragma unroll
                for (int m = 0; m < 4; ++m) { const int rl = ai * 128 + wr * 64 + m * 16 + fr, row = u.pm * 256 + rl;
                    bf16_t* rowp = O1 + (size_t)row * ld1 + (u.pn - nsplit) * 256 + cl;
                    const float* rt = RT + ((size_t)tokpos(row) * 32 + i0) * 2;
                    const pg8::f32x4 cs0 = *(const pg8::f32x4*)rt, cs1 = *(const pg8::f32x4*)(rt + 4);
#pragma unroll
                    for (int bj = 0; bj < 2; ++bj) { const pg8::f32x4 p = *(const LAS pg8::f32x4*)(xs + (rl * 2 + bj) * 4);
                        const float tot = wc < 2 ? p[0] + p[1] : p[2] + p[3];
                        const float rstd = oscale / sqrtf(tot * (1.f / 64.f) + EPS);
                        const pg8::f32x4 a0 = acc[ai][bj][m][0], a1 = acc[ai][bj][m][1];
                        const float y0 = a0[0] * rstd * ga[0], y1 = a0[1] * rstd * ga[1], y2 = a0[2] * rstd * ga[2], y3 = a0[3] * rstd * ga[3];
                        const float y4 = a1[0] * rstd * ga[4], y5 = a1[1] * rstd * ga[5], y6 = a1[2] * rstd * ga[6], y7 = a1[3] * rstd * ga[7];
                        u32x4 w;
                        w.x = pk2(y0 * cs0[0] - y1 * cs0[1], y1 * cs0[0] + y0 * cs0[1]);
                        w.y = pk2(y2 * cs0[2] - y3 * cs0[3], y3 * cs0[2] + y2 * cs0[3]);
                        w.z = pk2(y4 * cs1[0] - y5 * cs1[1], y5 * cs1[0] + y4 * cs1[1]);
                        w.w = pk2(y6 * cs1[2] - y7 * cs1[3], y7 * cs1[2] + y6 * cs1[3]);
                        *(u32x4*)(rowp + bj * 128) = w; } __builtin_amdgcn_sched_barrier(0); }
        }
    }
};
struct EpiVT {
    static constexpr bool PERM = false, AFTER_DRAIN = false, HAS_MID = false;
    bf16_t* O;
    __device__ __forceinline__ void operator()(const pg8::f32x4 (&acc)[2][2][4][2], const pg8::Unit& u, int wr, int wc, int fr, int fq) const {
        const int pos = (fq & 1) * 8 + (fq >> 1) * 4;
#pragma unroll
        for (int ai = 0; ai < 2; ++ai)
#pragma unroll
            for (int m = 0; m < 4; ++m) { bf16_t* rowp = O + (size_t)(u.pm * 256 + ai * 128 + wr * 64 + m * 16 + fr) * VTP + u.pn * 256 + wc * 32 + pos;
#pragma unroll
                for (int bj = 0; bj < 2; ++bj)
#pragma unroll
                    for (int n = 0; n < 2; ++n) { const pg8::f32x4 v = acc[ai][bj][m][n]; u32x2 w; w.x = pk2(v[0], v[1]); w.y = pk2(v[2], v[3]);
                        *(u32x2*)(rowp + bj * 128 + n * 16) = w; } }
    }
};
__device__ __forceinline__ float sigmoidf_(float x) { return 1.0f / (1.0f + __expf(-x)); }
struct EpiX1 {
    static constexpr bool PERM = true, AFTER_DRAIN = false, HAS_MID = false;
    const float* xp; const float* xs_; float* Y; bf16_t* X1B; float* SS;
    __device__ __forceinline__ void operator()(const pg8::f32x4 (&acc)[2][2][4][2], const pg8::Unit& u, int wr, int wc, int fr, int fq) const {
        const int row0 = u.pm * 256 + wr * 64 + fr, col0 = u.pn * 256 + wc * 32 + 8 * fq;
#pragma unroll
        for (int ai = 0; ai < 2; ++ai)
#pragma unroll
            for (int m = 0; m < 4; ++m) { const int row = row0 + ai * 128 + m * 16; const size_t ro = (size_t)row * DM + col0;
                const float* xr = row < MP ? xp + ro : xs_ + (ro - (size_t)MP * DM);
                float ss = 0.f;
#pragma unroll
                for (int bj = 0; bj < 2; ++bj) { const pg8::f32x4 x0 = __builtin_nontemporal_load((const pg8::f32x4*)(xr + bj * 128)), x1 = __builtin_nontemporal_load((const pg8::f32x4*)(xr + bj * 128 + 4));
                    const pg8::f32x4 o0 = x0 + acc[ai][bj][m][0], o1 = x1 + acc[ai][bj][m][1];
                    *(pg8::f32x4*)(Y + ro + bj * 128) = o0; *(pg8::f32x4*)(Y + ro + bj * 128 + 4) = o1;
                    u32x4 w; w.x = pk2(o0[0], o0[1]); w.y = pk2(o0[2], o0[3]); w.z = pk2(o1[0], o1[1]); w.w = pk2(o1[2], o1[3]);
                    *(u32x4*)(X1B + ro + bj * 128) = w;
                    ss += (o0[0] * o0[0] + o0[1] * o0[1]) + (o0[2] * o0[2] + o0[3] * o0[3]) + (o1[0] * o1[0] + o1[1] * o1[1]) + (o1[2] * o1[2] + o1[3] * o1[3]); }
                ss += __shfl_xor(ss, 16); ss += __shfl_xor(ss, 32);
                if (fq == 0) unsafeAtomicAdd(SS + row, ss); }
    }
};
struct EpiY {
    static constexpr bool PERM = true, AFTER_DRAIN = false, HAS_MID = false;
    float* Y;
    __device__ __forceinline__ void operator()(const pg8::f32x4 (&acc)[2][2][4][2], const pg8::Unit& u, int wr, int wc, int fr, int fq) const {
        const int row0 = u.pm * 256 + wr * 64 + fr, col0 = u.pn * 256 + wc * 32 + 8 * fq;
#pragma unroll
        for (int ai = 0; ai < 2; ++ai)
#pragma unroll
            for (int m = 0; m < 4; ++m) { float* rp = Y + (size_t)(row0 + ai * 128 + m * 16) * DM + col0;
#pragma unroll
                for (int bj = 0; bj < 2; ++bj) { const pg8::f32x4 x0 = __builtin_nontemporal_load((const pg8::f32x4*)(rp + bj * 128)), x1 = __builtin_nontemporal_load((const pg8::f32x4*)(rp + bj * 128 + 4));
                    *(pg8::f32x4*)(rp + bj * 128) = x0 + acc[ai][bj][m][0]; *(pg8::f32x4*)(rp + bj * 128 + 4) = x1 + acc[ai][bj][m][1]; } }
    }
};

struct EpiPart {
    static constexpr bool PERM = true, AFTER_DRAIN = false, HAS_MID = false;
    float* P;
    __device__ __forceinline__ void operator()(const pg8::f32x4 (&acc)[2][2][4][2], const pg8::Unit& u, int wr, int wc, int fr, int fq) const {
        int row0 = wr * 64 + fr; const int col0 = u.pn * 256 + wc * 32 + 8 * fq;
        asm volatile("" : "+v"(row0));
        float* base = P + (size_t)(u.kofs >> 8) * 256 * DM;
#pragma unroll
        for (int ai = 0; ai < 2; ++ai)
#pragma unroll
            for (int m = 0; m < 4; ++m) { float* rp = base + (size_t)(row0 + ai * 128 + m * 16) * DM + col0;
#pragma unroll
                for (int bj = 0; bj < 2; ++bj) { *(pg8::f32x4*)(rp + bj * 128) = acc[ai][bj][m][0]; *(pg8::f32x4*)(rp + bj * 128 + 4) = acc[ai][bj][m][1]; } }
    }
};

struct EpiMerge {
    static constexpr bool PERM = true, AFTER_DRAIN = false, HAS_MID = true;
    const bf16_t* GA; const bf16_t* GB; bf16_t* MB;
    __device__ __forceinline__ void mid(pg8::f32x4 (&acc)[2][2][4][2], const pg8::Unit& u, int wr, int wc, int fr, int fq) const {
        int row0 = u.pm * 256 + wr * 64 + fr; const int col0 = u.pn * 256 + wc * 32 + 8 * fq;
        asm volatile("" : "+v"(row0));
#pragma unroll
        for (int ai = 0; ai < 2; ++ai)
#pragma unroll
            for (int m = 0; m < 4; ++m) { const size_t ro = (size_t)(row0 + ai * 128 + m * 16) * DM + col0;
#pragma unroll
                for (int bj = 0; bj < 2; ++bj) { const u32x4 ga = __builtin_nontemporal_load((const u32x4*)(GA + ro + bj * 128)), gb = *(const u32x4*)(GB + ro + bj * 128);
                    const float a[8] = {bflo(ga.x), bfhi(ga.x), bflo(ga.y), bfhi(ga.y), bflo(ga.z), bfhi(ga.z), bflo(ga.w), bfhi(ga.w)};
                    const float b[8] = {bflo(gb.x), bfhi(gb.x), bflo(gb.y), bfhi(gb.y), bflo(gb.z), bfhi(gb.z), bflo(gb.w), bfhi(gb.w)};
#pragma unroll
                    for (int j = 0; j < 8; ++j) { const float r = (1.0f + __expf(-b[j])) / (1.0f + __expf(-a[j])); acc[ai][bj][m][j >> 2][j & 3] *= r; } } }
    }
    __device__ __forceinline__ void operator()(const pg8::f32x4 (&acc)[2][2][4][2], const pg8::Unit& u, int wr, int wc, int fr, int fq) const {
        int row0 = u.pm * 256 + wr * 64 + fr; const int col0 = u.pn * 256 + wc * 32 + 8 * fq;
        asm volatile("" : "+v"(row0));
#pragma unroll
        for (int ai = 0; ai < 2; ++ai)
#pragma unroll
            for (int m = 0; m < 4; ++m) { const size_t ro = (size_t)(row0 + ai * 128 + m * 16) * DM + col0;
#pragma unroll
                for (int bj = 0; bj < 2; ++bj) { const u32x4 g = *(const u32x4*)(GB + ro + bj * 128);
                    const pg8::f32x4 a0 = acc[ai][bj][m][0], a1 = acc[ai][bj][m][1];
                    u32x4 w;
                    w.x = pk2(a0[0] * sigmoidf_(bflo(g.x)), a0[1] * sigmoidf_(bfhi(g.x)));
                    w.y = pk2(a0[2] * sigmoidf_(bflo(g.y)), a0[3] * sigmoidf_(bfhi(g.y)));
                    w.z = pk2(a1[0] * sigmoidf_(bflo(g.z)), a1[1] * sigmoidf_(bfhi(g.z)));
                    w.w = pk2(a1[2] * sigmoidf_(bflo(g.w)), a1[3] * sigmoidf_(bfhi(g.w)));
                    *(u32x4*)(MB + ro + bj * 128) = w; } }
    }
};

typedef float f32x2e __attribute__((ext_vector_type(2)));
__device__ __forceinline__ f32x2e gelu_pk2(f32x2e v) {
    const f32x2e av = __builtin_elementwise_abs(v), d = av * 0.2316418882f + 1.0f;
    f32x2e t; t.x = __builtin_amdgcn_rcpf(d.x); t.y = __builtin_amdgcn_rcpf(d.y);
    f32x2e q = t * 0.5307027145f + (-0.7265760135f); q = q * t + 0.7107068705f; q = q * t + (-0.142248368f); q = q * t + 0.127414796f; q = q * t;
    const f32x2e s = (v * v) * (-0.72134752044f);
    f32x2e e; e.x = __builtin_amdgcn_exp2f(s.x); e.y = __builtin_amdgcn_exp2f(s.y);
    const f32x2e m = v * (q * e), r = v - m;
    f32x2e o; o.x = v.x < 0.f ? m.x : r.x; o.y = v.y < 0.f ? m.y : r.y; return o;
}
__device__ __forceinline__ float dpp_shr1(float v, float old) { return __int_as_float(__builtin_amdgcn_update_dpp(__float_as_int(old), __float_as_int(v), 0x111, 0xf, 0xf, false)); }
__device__ __forceinline__ float dpp_shr2(float v, float old) { return __int_as_float(__builtin_amdgcn_update_dpp(__float_as_int(old), __float_as_int(v), 0x112, 0xf, 0xf, false)); }
struct EpiUpG {
    static constexpr bool PERM = true, AFTER_DRAIN = false, HAS_MID = false;
    bf16_t* Gb; const float* SS; float* out; const float* cw; const float* cb; const float* hist; float* side;
    __device__ __forceinline__ void operator()(const pg8::f32x4 (&acc)[2][2][4][2], const pg8::Unit& u, int wr, int wc, int fr, int fq) const {
        int cl = wc * 32 + 8 * fq; asm volatile("" : "+v"(cl));
        const int lane = fq * 16 + fr, col = u.pn * 128 + cl;
        const bool sample = u.pm == MP / 256;
        float* AH = side; float* AF0 = side + 33 * 8 * DFF; float* GT0 = side + 2 * 33 * 8 * DFF;
        float w0[8], w1[8], w2[8], wb[8];
#pragma unroll
        for (int j = 0; j < 8; j += 4) { const pg8::f32x4 t0 = *(const pg8::f32x4*)(cw + col + j), t1 = *(const pg8::f32x4*)(cw + DFF + col + j), t2 = *(const pg8::f32x4*)(cw + 2 * DFF + col + j), t3 = *(const pg8::f32x4*)(cb + col + j);
#pragma unroll
            for (int e = 0; e < 4; ++e) { w0[j + e] = t0[e]; w1[j + e] = t1[e]; w2[j + e] = t2[e]; wb[j + e] = t3[e]; } }
#pragma unroll
        for (int ai = 0; ai < 2; ++ai) {
            float prev[8];
#pragma unroll
            for (int e = 0; e < 8; ++e) prev[e] = 0.f;
#pragma unroll
            for (int m = 0; m < 4; ++m) {
                const int row_l = ai * 128 + wr * 64 + m * 16 + fr, row = u.pm * 256 + row_l, blk = ai * 2 + wr;
                const float rstd = 1.0f / sqrtf(SS[row] * (1.f / 2048.f) + EPS);
                float av[8], gv[8], b1[8], b2[8];
#pragma unroll
                for (int e = 0; e < 8; ++e) { av[e] = acc[ai][0][m][e >> 2][e & 3] * rstd; gv[e] = acc[ai][1][m][e >> 2][e & 3] * rstd; b1[e] = 0.f; b2[e] = 0.f; }
                if (sample) {
                    if (fr < 2) { const float* hp = hist + (size_t)(row_l >> 4) * 2 * DFF + col;
#pragma unroll
                        for (int e = 0; e < 8; ++e) { b1[e] = hp[DFF + e]; b2[e] = fr == 0 ? hp[e] : hp[DFF + e]; } }
                } else if (m > 0) {
#pragma unroll
                    for (int e = 0; e < 8; ++e) { b1[e] = __shfl(prev[e], (lane & 48) | 15); b2[e] = __shfl(prev[e], (lane & 48) | (14 + (fr & 1))); }
                }
                const bool defer = !sample && m == 0 && fr < 2;
                float y[8];
#pragma unroll
                for (int e = 0; e < 8; e += 2) {
                    const float a1x = dpp_shr1(av[e], b1[e]), a1y = dpp_shr1(av[e + 1], b1[e + 1]), a2x = dpp_shr2(av[e], b2[e]), a2y = dpp_shr2(av[e + 1], b2[e + 1]);
                    f32x2e cv; cv.x = wb[e] + w2[e] * av[e] + w1[e] * a1x + w0[e] * a2x;
                    cv.y = wb[e + 1] + w2[e + 1] * av[e + 1] + w1[e + 1] * a1y + w0[e + 1] * a2y;
                    const f32x2e ge = gelu_pk2(cv); y[e] = ge.x * gv[e]; y[e + 1] = ge.y * gv[e + 1]; }
                if (!defer) { u32x4 o; o.x = pk2(y[0], y[1]); o.y = pk2(y[2], y[3]); o.z = pk2(y[4], y[5]); o.w = pk2(y[6], y[7]);
                    *(u32x4*)(Gb + (size_t)row * DFF + col) = o; }
                else { float* pa_ = AF0 + ((size_t)(u.pm * 4 + blk) * 2 + fr) * DFF + col; float* pg_ = GT0 + ((size_t)(u.pm * 4 + blk) * 2 + fr) * DFF + col;
#pragma unroll
                    for (int e = 0; e < 8; ++e) { pa_[e] = av[e]; pg_[e] = gv[e]; } }
                if (m == 3 && fr >= 14) { float* ph = AH + ((size_t)(u.pm * 4 + blk) * 2 + (fr - 14)) * DFF + col;
#pragma unroll
                    for (int e = 0; e < 8; ++e) ph[e] = av[e]; }
                {
                    float* fc = nullptr;
                    if (row < MP) { const int t = row & (TP - 1); if (t >= TP - 2) fc = out + O_FCP + ((size_t)(row >> 12) * 2 + (t - (TP - 2))) * DFF + col; }
                    else { const int r = row - MP, t = r & 15; if (t >= 14) fc = out + O_FCS + ((size_t)(r >> 4) * 2 + (t - 14)) * DFF + col; }
                    if (fc) {
#pragma unroll
                        for (int e = 0; e < 8; ++e) fc[e] = av[e]; }
                }
#pragma unroll
                for (int e = 0; e < 8; ++e) prev[e] = av[e];
                __builtin_amdgcn_sched_barrier(0);
            }
        }
    }
};

constexpr int GS_Q = 0, GS_KT = 33792, GS_VT = 70656, GS_EB = 75264, GS_STAGE = 76288;
__device__ __forceinline__ bf16x8 pack8(const f32x16& v, int b) {
    u32x4 w; w.x = pk2(v[b], v[b + 1]); w.y = pk2(v[b + 2], v[b + 3]); w.z = pk2(v[b + 4], v[b + 5]); w.w = pk2(v[b + 6], v[b + 7]); return __builtin_bit_cast(bf16x8, w);
}
struct GlaStageRegs { u32x4 q[6], k[6]; u32x2 v[2]; u32x4 e; };
__device__ __forceinline__ void gla_stage_issue(const Args& a, GlaStageRegs& R, int hw, int lane, int rowc, int h, int vs, int ci, int nvalid) {
    asm volatile("" : "+v"(lane));
    unsigned char* ws = a.ws;
    const bf16_t* ZQ = (const bf16_t*)(ws + WS_ZQ); const bf16_t* ZKT = (const bf16_t*)(ws + WS_ZKT); const bf16_t* ZV = (const bf16_t*)(ws + WS_ZV); const float* EBL = (const float*)(ws + WS_EBL);
    const u32x4 z4 = {0u, 0u, 0u, 0u};
    R.e = z4;
#pragma unroll
    for (int i = 0; i < 6; ++i) { const int c = hw * 64 + lane + 384 * i; R.q[i] = z4; R.k[i] = z4;
        if (c < 2048) { const int row = c >> 5, cc = c & 31; if (row < nvalid) R.q[i] = *(const u32x4*)(ZQ + (size_t)(rowc + row) * 1024 + h * 256 + 8 * cc);
                        const int d = c >> 3, kc = c & 7; if (8 * kc < nvalid) R.k[i] = *(const u32x4*)(ZKT + (size_t)(h * 256 + d) * MA + rowc + 8 * kc); } }
#pragma unroll
    for (int i = 0; i < 2; ++i) { const int c = hw * 64 + lane + 384 * i; R.v[i] = (u32x2){0u, 0u};
        if (c < 512) { const int s = c >> 3, v4 = (c & 7) * 4; if (s < nvalid) R.v[i] = __builtin_nontemporal_load((const u32x2*)(ZV + (size_t)(rowc + s) * 2048 + h * 512 + vs * 32 + v4)); } }
    { const int c = hw * 64 + lane; if (c < 64) R.e = *(const u32x4*)(EBL + (size_t)ci * 1024 + h * 256 + 4 * c); }
}
__device__ __forceinline__ void gla_stage_commit(LAS unsigned char* st, const GlaStageRegs& R, int hw, int lane) {
    asm volatile("" : "+v"(lane));
#pragma unroll
    for (int i = 0; i < 6; ++i) { const int c = hw * 64 + lane + 384 * i;
        if (c < 2048) { *(LAS u32x4*)(st + GS_Q + (c >> 5) * 528 + (c & 31) * 16) = R.q[i]; *(LAS u32x4*)(st + GS_KT + (c >> 3) * 144 + (c & 7) * 16) = R.k[i]; } }
#pragma unroll
    for (int i = 0; i < 2; ++i) { const int c = hw * 64 + lane + 384 * i;
        if (c < 512) { const int s = c >> 3, v4 = (c & 7) * 4; LAS bf16_t* vt = (LAS bf16_t*)(st + GS_VT);
            vt[(v4 + 0) * 72 + s] = (bf16_t)(R.v[i].x & 0xffffu); vt[(v4 + 1) * 72 + s] = (bf16_t)(R.v[i].x >> 16); vt[(v4 + 2) * 72 + s] = (bf16_t)(R.v[i].y & 0xffffu); vt[(v4 + 3) * 72 + s] = (bf16_t)(R.v[i].y >> 16); } }
    { const int c = hw * 64 + lane; if (c < 64) *(LAS u32x4*)(st + GS_EB + c * 16) = R.e; }
}
__device__ __forceinline__ void gla_item(const Args& a, LAS unsigned char* lds, int it) {
    int tid_ = threadIdx.x; asm volatile("" : "+v"(tid_)); const int tid = tid_, lane = tid & 63, wave = __builtin_amdgcn_readfirstlane(tid >> 6), l32 = lane & 31, hi = lane >> 5;
    unsigned char* ws = a.ws;
    bf16_t* ZV = (bf16_t*)(ws + WS_ZV); const bf16_t* AF = (const bf16_t*)(ws + WS_AF);
    {
        int seq, h, vs, nchunk, row0, ci0, nvalid; const float* S0 = nullptr;
        if (it < 128) { seq = it >> 6; h = (it >> 4) & 3; vs = it & 15; nchunk = 64; row0 = seq * TP; ci0 = seq * 64; nvalid = 64; }
        else { const int j = it - 128, st = j >> 6; h = (j >> 4) & 3; vs = j & 15; seq = 2 + st; nchunk = 1; row0 = MP + st * 16; ci0 = 128 + st; nvalid = 16; S0 = a.in[2] + (size_t)((st * 4 + h) * 256) * 512; }
        float* SO = a.out + O_ST + (size_t)((seq * 4 + h) * 256) * 512;
        f32x16 S[4]; GlaStageRegs R;
        const int dw = wave * 4;
        if (wave < 2) {
#pragma unroll
            for (int db = 0; db < 4; ++db)
#pragma unroll
                for (int r = 0; r < 16; ++r) S[db][r] = S0 ? __builtin_nontemporal_load(S0 + (size_t)(32 * (dw + db) + crow(r, hi)) * 512 + vs * 32 + l32) : 0.f;
        } else { gla_stage_issue(a, R, wave - 2, lane, row0, h, vs, ci0, nvalid); gla_stage_commit(lds, R, wave - 2, lane);
                 if (nchunk > 1) gla_stage_issue(a, R, wave - 2, lane, row0 + 64, h, vs, ci0 + 1, nvalid); }
        if (threadIdx.x == 64) *(volatile LAS unsigned*)(lds + 2 * GS_STAGE + 8) = 0u;
        __syncthreads();
        LAS float* XO = (LAS float*)(lds + 2 * GS_STAGE + 16);
        volatile LAS unsigned* xflag = (volatile LAS unsigned*)(lds + 2 * GS_STAGE + 8);
        if (wave < 2) __builtin_amdgcn_s_setprio(3);
        for (int c = 0; c < nchunk; ++c) {
            LAS unsigned char* st = lds + (c & 1) * GS_STAGE;
            f32x16 o0 = {}, o1 = {};
            if (wave >= 2) { if (c + 1 < nchunk) { gla_stage_commit(lds + ((c + 1) & 1) * GS_STAGE, R, wave - 2, lane);
                                                   if (c + 2 < nchunk) gla_stage_issue(a, R, wave - 2, lane, row0 + 64 * (c + 2), h, vs, ci0 + c + 2, nvalid); } }
            else {
                int l32 = lane & 31, hi = lane >> 5; asm volatile("" : "+v"(l32), "+v"(hi));
                const LAS bf16_t* Qs = (const LAS bf16_t*)(st + GS_Q);
#pragma unroll
                for (int db = 0; db < 4; ++db)
#pragma unroll
                    for (int j = 0; j < 2; ++j) { const bf16x8 sf = pack8(S[db], 8 * j);
                        const bf16x8 q0 = *(const LAS bf16x8*)(Qs + l32 * 264 + 32 * (dw + db) + 16 * j + 8 * hi), q1 = *(const LAS bf16x8*)(Qs + (32 + l32) * 264 + 32 * (dw + db) + 16 * j + 8 * hi);
                        o0 = __builtin_amdgcn_mfma_f32_32x32x16_bf16(q0, sf, o0, 0, 0, 0); o1 = __builtin_amdgcn_mfma_f32_32x32x16_bf16(q1, sf, o1, 0, 0, 0);
                        __builtin_amdgcn_sched_barrier(0); }
                if (wave == 1) {
#pragma unroll
                    for (int r = 0; r < 16; ++r) { XO[r * 64 + lane] = o0[r]; XO[(16 + r) * 64 + lane] = o1[r]; }
                    asm volatile("s_waitcnt lgkmcnt(0)" ::: "memory");
                    if (lane == 0) xflag[0] = (unsigned)(c + 1);
                } else {
                    while (xflag[0] != (unsigned)(c + 1)) __builtin_amdgcn_s_sleep(1);
                    asm volatile("" ::: "memory");
                }
            }
            if (wave < 2) {
                int l32 = lane & 31, hi = lane >> 5; asm volatile("" : "+v"(l32), "+v"(hi));
                const LAS bf16_t* KT = (const LAS bf16_t*)(st + GS_KT); const LAS bf16_t* VT = (const LAS bf16_t*)(st + GS_VT);
                const LAS float* EB = (const LAS float*)(st + GS_EB);
                if (wave == 0) {
                    const int rowc = row0 + 64 * c;
#pragma unroll
                    for (int r = 0; r < 16; ++r) { o0[r] += XO[r * 64 + lane]; o1[r] += XO[(16 + r) * 64 + lane]; }
                    const bf16_t* afp = AF + ((size_t)((ci0 + c) * 4 + h) * 3 * 64 + lane) * 16;
                    bf16x8 af[3][2];
#pragma unroll
                    for (int tl = 0; tl < 3; ++tl) { af[tl][0] = *(const bf16x8*)(afp + (size_t)tl * 1024); af[tl][1] = *(const bf16x8*)(afp + (size_t)tl * 1024 + 8); }
#pragma unroll
                    for (int tl = 0; tl < 3; ++tl) { const int sb = tl == 2 ? 1 : 0;
#pragma unroll
                        for (int j = 0; j < 2; ++j) { const LAS bf16_t* vp = VT + l32 * 72 + 32 * sb + 16 * j + 4 * hi;
                            const u32x2 lo = *(const LAS u32x2*)vp, hi2 = *(const LAS u32x2*)(vp + 8);
                            const bf16x8 vf = __builtin_bit_cast(bf16x8, (u32x4){lo.x, lo.y, hi2.x, hi2.y});
                            if (tl == 0) o0 = __builtin_amdgcn_mfma_f32_32x32x16_bf16(af[tl][j], vf, o0, 0, 0, 0);
                            else o1 = __builtin_amdgcn_mfma_f32_32x32x16_bf16(af[tl][j], vf, o1, 0, 0, 0); } }
#pragma unroll
                    for (int r = 0; r < 16; ++r) { const int t = crow(r, hi);
                        if (t < nvalid) ZV[(size_t)(rowc + t) * 2048 + h * 512 + vs * 32 + l32] = (bf16_t)(pk2(o0[r], 0.f) & 0xffffu);
                        if (32 + t < nvalid) ZV[(size_t)(rowc + 32 + t) * 2048 + h * 512 + vs * 32 + l32] = (bf16_t)(pk2(o1[r], 0.f) & 0xffffu); }
                    __builtin_amdgcn_sched_barrier(0);
                }
#pragma unroll
                for (int db = 0; db < 4; ++db) { f32x16 acc = S[db];
#pragma unroll
                    for (int ks = 0; ks < 4; ++ks) { const bf16x8 kf = *(const LAS bf16x8*)(KT + (32 * (dw + db) + l32) * 72 + 16 * ks + 8 * hi), vf = *(const LAS bf16x8*)(VT + l32 * 72 + 16 * ks + 8 * hi);
                        acc = __builtin_amdgcn_mfma_f32_32x32x16_bf16(kf, vf, acc, 0, 0, 0); }
#pragma unroll
                    for (int q4 = 0; q4 < 4; ++q4) { const f32x4 e = *(const LAS f32x4*)(EB + 32 * (dw + db) + 8 * q4 + 4 * hi);
                        acc[4 * q4] *= e[0]; acc[4 * q4 + 1] *= e[1]; acc[4 * q4 + 2] *= e[2]; acc[4 * q4 + 3] *= e[3]; }
                    S[db] = acc; __builtin_amdgcn_sched_barrier(0); }
            }
            __syncthreads();
        }
        __builtin_amdgcn_s_setprio(0);
        if (wave < 2) {
#pragma unroll
            for (int db = 0; db < 4; ++db)
#pragma unroll
                for (int r = 0; r < 16; ++r) SO[(size_t)(32 * (dw + db) + crow(r, hi)) * 512 + vs * 32 + l32] = S[db][r];
        }
        __syncthreads();
    }
}
__device__ __forceinline__ void gla_phase(const Args& a, LAS unsigned char* lds, int chain, int nscan) {
    unsigned* ctr = (unsigned*)(a.ws + WS_CTR); volatile LAS unsigned* bc = (volatile LAS unsigned*)(lds + 2 * GS_STAGE);
    for (;;) {
        int it;
        if (chain < 128) { it = chain; chain += nscan; }
        else {
            if (threadIdx.x == 0) bc[0] = atomicAdd(ctr, 1u);
            __syncthreads();
            const unsigned j = bc[0];
            __syncthreads();
            if (j >= 1024u) break;
            it = 128 + (int)j;
        }
        gla_item(a, lds, it);
    }
}
__device__ __forceinline__ void gla_norm(const Args& a, int G) {
    int tid_ = threadIdx.x; asm volatile("" : "+v"(tid_)); const int tid = tid_, lane = tid & 63, wave = __builtin_amdgcn_readfirstlane(tid >> 6), gw = blockIdx.x * 8 + wave, NGW = G * 8;
    const bf16_t* ZV = (const bf16_t*)(a.ws + WS_ZV); const bf16_t* ZR = (const bf16_t*)(a.ws + WS_ZR); bf16_t* OG = (bf16_t*)(a.out + O_Y); const float* go = a.in[10];
    const f32x4 g0 = *(const f32x4*)(go + 8 * lane), g1 = *(const f32x4*)(go + 8 * lane + 4);
    const float gg[8] = {g0.x, g0.y, g0.z, g0.w, g1.x, g1.y, g1.z, g1.w};
    for (int it0 = gw; it0 < MA * 4; it0 += 4 * NGW) {
        u32x4 w[4], rr[4]; float ss[4];
#pragma unroll
        for (int u = 0; u < 4; ++u) { const int it = it0 + u * NGW; if (it < MA * 4) { const size_t o = (size_t)(it >> 2) * 2048 + (it & 3) * 512 + 8 * lane; w[u] = __builtin_nontemporal_load((const u32x4*)(ZV + o)); rr[u] = __builtin_nontemporal_load((const u32x4*)(ZR + o)); }
            else { w[u] = (u32x4){0u, 0u, 0u, 0u}; rr[u] = w[u]; } }
#pragma unroll
        for (int u = 0; u < 4; ++u) { float x[8]; unpack8(w[u], x); float s_ = 0.f;
#pragma unroll
            for (int j = 0; j < 8; ++j) s_ += x[j] * x[j];
            ss[u] = s_; }
#pragma unroll
        for (int o_ = 1; o_ < 64; o_ <<= 1) {
#pragma unroll
            for (int u = 0; u < 4; ++u) ss[u] += __shfl_xor(ss[u], o_); }
#pragma unroll
        for (int u = 0; u < 4; ++u) { const int it = it0 + u * NGW; if (it < MA * 4) { const int m = it >> 2, h = it & 3;
            float x[8], r[8]; unpack8(w[u], x); unpack8(rr[u], r);
            const float rstd = 1.0f / sqrtf(ss[u] * (1.f / 512.f) + EPS);
            float y[8];
#pragma unroll
            for (int j = 0; j < 8; ++j) y[j] = x[j] * rstd * gg[j] * (r[j] / (1.0f + __expf(-r[j])));
            u32x4 ow; ow.x = pk2(y[0], y[1]); ow.y = pk2(y[2], y[3]); ow.z = pk2(y[4], y[5]); ow.w = pk2(y[6], y[7]);
            *(u32x4*)(OG + (size_t)m * 4096 + h * 512 + 8 * lane) = ow; } }
    }
}

constexpr float ATT_C = 0.07216878364870322f * 1.4426950408889634f;
template <class KF, class VF>
__device__ __forceinline__ void attn_tile(const bf16x8 (&qf)[12], float& l, f32x16 (&o)[4], const KF& kf, const VF& vf, int nvalid, int hi) {
    f32x16 p0 = {}, p1 = {};
    bf16x8 fa[4], fb[4];
#define AT_LDK(dst, g) do { dst[0] = kf(0, 2 * (g)); dst[1] = kf(1, 2 * (g)); dst[2] = kf(0, 2 * (g) + 1); dst[3] = kf(1, 2 * (g) + 1); } while (0)
#define AT_LDV(dst, vb) do { dst[0] = vf(vb, 0); dst[1] = vf(vb, 1); dst[2] = vf(vb, 2); dst[3] = vf(vb, 3); } while (0)
#define AT_QK(src, g) do { p0 = __builtin_amdgcn_mfma_f32_32x32x16_bf16(src[0], qf[2 * (g)], p0, 0, 0, 0); p1 = __builtin_amdgcn_mfma_f32_32x32x16_bf16(src[1], qf[2 * (g)], p1, 0, 0, 0); \
        p0 = __builtin_amdgcn_mfma_f32_32x32x16_bf16(src[2], qf[2 * (g) + 1], p0, 0, 0, 0); p1 = __builtin_amdgcn_mfma_f32_32x32x16_bf16(src[3], qf[2 * (g) + 1], p1, 0, 0, 0); } while (0)
#define AT_SB __builtin_amdgcn_sched_barrier(0)
    AT_LDK(fa, 0); AT_SB;
    AT_LDK(fb, 1); AT_SB; AT_QK(fa, 0); AT_SB;
    AT_LDK(fa, 2); AT_SB; AT_QK(fb, 1); AT_SB;
    AT_LDK(fb, 3); AT_SB; AT_QK(fa, 2); AT_SB;
    AT_LDK(fa, 4); AT_SB; AT_QK(fb, 3); AT_SB;
    AT_LDK(fb, 5); AT_SB; AT_QK(fa, 4); AT_SB;
    AT_LDV(fa, 0); AT_SB; AT_QK(fb, 5); AT_SB;
    if (nvalid < 64) {
#pragma unroll
        for (int r = 0; r < 16; ++r) { if (crow(r, hi) >= nvalid) p0[r] = -INFINITY; if (32 + crow(r, hi) >= nvalid) p1[r] = -INFINITY; }
    }
    float ls = 0.f;
#pragma unroll
    for (int r = 0; r < 16; ++r) { p0[r] = __builtin_amdgcn_exp2f(p0[r]); p1[r] = __builtin_amdgcn_exp2f(p1[r]); ls += p0[r] + p1[r]; }
    l += ls;
    const bf16x8 pa[4] = {pack8(p0, 0), pack8(p0, 8), pack8(p1, 0), pack8(p1, 8)};
#define AT_PV(src, vb) do { _Pragma("unroll") for (int c = 0; c < 4; ++c) o[vb] = __builtin_amdgcn_mfma_f32_32x32x16_bf16(src[c], pa[c], o[vb], 0, 0, 0); } while (0)
    AT_SB;
    AT_LDV(fb, 1); AT_SB; AT_PV(fa, 0); AT_SB;
    AT_LDV(fa, 2); AT_SB; AT_PV(fb, 1); AT_SB;
    AT_LDV(fb, 3); AT_SB; AT_PV(fa, 2); AT_SB;
    AT_PV(fb, 3); AT_SB;
#undef AT_LDK
#undef AT_LDV
#undef AT_QK
#undef AT_PV
#undef AT_SB
}
template <class KF, class VF>
__device__ __forceinline__ void attn_tile_s(const LAS unsigned char* qs, int lane, float& l, f32x16 (&o)[4], const KF& kf, const VF& vf, int nvalid, int hi) {
    f32x16 p0 = {}, p1 = {};
    bf16x8 f[16];
#define AT_SB __builtin_amdgcn_sched_barrier(0)
#pragma unroll
    for (int ks = 0; ks < 8; ++ks) { f[2 * ks] = kf(0, ks); f[2 * ks + 1] = kf(1, ks); }
    AT_SB;
#pragma unroll
    for (int ks = 0; ks < 8; ++ks) { const bf16x8 q = *(const LAS bf16x8*)(qs + ks * 1024 + lane * 16);
        p0 = __builtin_amdgcn_mfma_f32_32x32x16_bf16(f[2 * ks], q, p0, 0, 0, 0); p1 = __builtin_amdgcn_mfma_f32_32x32x16_bf16(f[2 * ks + 1], q, p1, 0, 0, 0); }
    AT_SB;
#pragma unroll
    for (int ks = 0; ks < 4; ++ks) { f[2 * ks] = kf(0, 8 + ks); f[2 * ks + 1] = kf(1, 8 + ks); }
#pragma unroll
    for (int i_ = 0; i_ < 8; ++i_) f[8 + i_] = vf(i_ >> 2, i_ & 3);
    AT_SB;
#pragma unroll
    for (int ks = 0; ks < 4; ++ks) { const bf16x8 q = *(const LAS bf16x8*)(qs + (8 + ks) * 1024 + lane * 16);
        p0 = __builtin_amdgcn_mfma_f32_32x32x16_bf16(f[2 * ks], q, p0, 0, 0, 0); p1 = __builtin_amdgcn_mfma_f32_32x32x16_bf16(f[2 * ks + 1], q, p1, 0, 0, 0); }
    AT_SB;
    bf16x8 g[8];
#pragma unroll
    for (int i_ = 0; i_ < 8; ++i_) g[i_] = vf(2 + (i_ >> 2), i_ & 3);
    AT_SB;
    if (nvalid < 64) {
#pragma unroll
        for (int r = 0; r < 16; ++r) { if (crow(r, hi) >= nvalid) p0[r] = -INFINITY; if (32 + crow(r, hi) >= nvalid) p1[r] = -INFINITY; }
    }
    float ls = 0.f;
#pragma unroll
    for (int r = 0; r < 16; ++r) { p0[r] = __builtin_amdgcn_exp2f(p0[r]); p1[r] = __builtin_amdgcn_exp2f(p1[r]); ls += p0[r] + p1[r]; }
    l += ls;
    const bf16x8 pa[4] = {pack8(p0, 0), pack8(p0, 8), pack8(p1, 0), pack8(p1, 8)};
    AT_SB;
#pragma unroll
    for (int i_ = 0; i_ < 8; ++i_) o[i_ >> 2] = __builtin_amdgcn_mfma_f32_32x32x16_bf16(f[8 + i_], pa[i_ & 3], o[i_ >> 2], 0, 0, 0);
    AT_SB;
#pragma unroll
    for (int i_ = 0; i_ < 8; ++i_) o[2 + (i_ >> 2)] = __builtin_amdgcn_mfma_f32_32x32x16_bf16(g[i_], pa[i_ & 3], o[2 + (i_ >> 2)], 0, 0, 0);
    AT_SB;
#undef AT_SB
}
struct KFLds { const LAS unsigned char* kn; const LAS unsigned char* kp; int l32, hi;
    __device__ __forceinline__ bf16x8 operator()(int p, int ks) const { const int row = 32 * p + l32;
        if (ks < 8) return *(const LAS bf16x8*)(kn + row * 256 + (((2 * ks + hi) ^ (row & 15)) << 4));
        return *(const LAS bf16x8*)(kp + row * 128 + (((2 * (ks - 8) + hi) ^ ((row >> 1) & 7)) << 4)); } };
struct VFLds { const LAS unsigned char* vt; int l32, hi;
    __device__ __forceinline__ bf16x8 operator()(int vb, int c) const { const int row = 32 * vb + l32; return *(const LAS bf16x8*)(vt + row * 128 + (((2 * c + hi) ^ ((row >> 1) & 7)) << 4)); } };
struct KFGlb { const bf16_t* kn; const bf16_t* kp; int hi;
    __device__ __forceinline__ bf16x8 operator()(int p, int ks) const {
        if (ks < 8) return *(const bf16x8*)(kn + (size_t)p * 32 * 2048 + 16 * ks + 8 * hi);
        return *(const bf16x8*)(kp + (size_t)p * 32 * 64 + 16 * (ks - 8) + 8 * hi); } };
struct VFGlb { const bf16_t* vt; int hi;
    __device__ __forceinline__ bf16x8 operator()(int vb, int c) const { return *(const bf16x8*)(vt + (size_t)vb * 32 * VTP + 16 * c + 8 * hi); } };

constexpr int AT_KN = 0, AT_KP = 16384, AT_VT = 24576, AT_BUF = 40960;
__device__ __forceinline__ void attention_phase(const Args& a, LAS unsigned char* lds, int G) {
    int tid_ = threadIdx.x; asm volatile("" : "+v"(tid_)); const int tid = tid_, lane = tid & 63, wave = __builtin_amdgcn_readfirstlane(tid >> 6), l32 = lane & 31, hi = lane >> 5;
    unsigned char* ws = a.ws;
    const bf16_t* QN = (const bf16_t*)(ws + WS_E); const bf16_t* QP = (const bf16_t*)(ws + WS_D);
    const bf16_t* KN = (const bf16_t*)(ws + WS_KN); const bf16_t* KPE = (const bf16_t*)(ws + WS_KPEALL); const bf16_t* VT = (const bf16_t*)(ws + WS_VT);
    bf16_t* ATT = (bf16_t*)(a.out + O_Y) + 2048;
    const int vcu = (G % 8 == 0) ? (blockIdx.x % 8) * (G / 8) + blockIdx.x / 8 : blockIdx.x;
    for (int pr = vcu; pr < 256; pr += G) {
        const int bh = pr >> 3, b = bh >> 4, h = bh & 15;
        for (int half = 0; half < 2; ++half) {
            const int qb = half == 0 ? (pr & 7) : 15 - (pr & 7), q0 = qb * 256, NT = (q0 >> 6) + 4, wch = (q0 >> 6) + (wave >> 1);
            const size_t qrow = (size_t)b * TP + q0 + wave * 32 + l32;
            bf16x8 qf[12];
#pragma unroll
            for (int ks = 0; ks < 8; ++ks) qf[ks] = __builtin_nontemporal_load((const bf16x8*)(QN + qrow * 2048 + h * 128 + 16 * ks + 8 * hi));
#pragma unroll
            for (int ks = 0; ks < 4; ++ks) qf[8 + ks] = __builtin_nontemporal_load((const bf16x8*)(QP + qrow * 1024 + h * 64 + 16 * ks + 8 * hi));
            float l = 0.f; f32x16 o[4] = {};
            const size_t kv0 = (size_t)b * TP;
#define AT_DMA(j, buf) do { const size_t kr = kv0 + 64 * (size_t)(j); LAS unsigned char* bb = lds + (buf) * AT_BUF; \
                _Pragma("unroll") for (int i = 0; i < 2; ++i) { const int rg = 2 * wave + i; \
                    { const int row = 4 * rg + (lq >> 4), ch = (lq & 15) ^ (row & 15); \
                      __builtin_amdgcn_global_load_lds((const unsigned*)(KN + (kr + row) * 2048 + h * 128 + 8 * ch), (LAS unsigned*)(bb + AT_KN + rg * 1024), 16, 0, 0); } \
                    { const int row = 8 * rg + (lq >> 3), ch = (lq & 7) ^ ((row >> 1) & 7); \
                      __builtin_amdgcn_global_load_lds((const unsigned*)(VT + (size_t)(h * 128 + row) * VTP + kr + 8 * ch), (LAS unsigned*)(bb + AT_VT + rg * 1024), 16, 0, 0); } } \
                { const int row = 8 * wave + (lq >> 3), ch = (lq & 7) ^ ((row >> 1) & 7); \
                  __builtin_amdgcn_global_load_lds((const unsigned*)(KPE + (kr + row) * 64 + 8 * ch), (LAS unsigned*)(bb + AT_KP + wave * 1024), 16, 0, 0); } } while (0)
            int lq = lane; asm volatile("" : "+v"(lq));
            AT_DMA(0, 0); AT_DMA(1, 1);
            int slot = 0;
            for (int j = 0; j < NT; ++j) {
                if (j + 1 < NT) asm volatile("s_waitcnt vmcnt(5)" ::: "memory"); else asm volatile("s_waitcnt vmcnt(0)" ::: "memory");
                __builtin_amdgcn_s_barrier(); asm volatile("" ::: "memory");
                lq = lane; asm volatile("" : "+v"(lq));
                { const int s2 = slot >= 1 ? slot - 1 : 2;
                  if (j + 2 < NT) AT_DMA(j + 2, s2); }
                if (j <= wch) {
                    const LAS unsigned char* bb = lds + slot * AT_BUF;
                    const KFLds kf{bb + AT_KN, bb + AT_KP, l32, hi}; const VFLds vf{bb + AT_VT, l32, hi};
                    attn_tile(qf, l, o, kf, vf, 64, hi);
                }
                slot = slot == 2 ? 0 : slot + 1;
                asm volatile("s_waitcnt lgkmcnt(0)" ::: "memory");
            }
            __syncthreads();
            l += __shfl_xor(l, 32); const float inv = 1.0f / l;
            bf16_t* op = ATT + qrow * 4096 + h * 128;
#pragma unroll
            for (int vb = 0; vb < 4; ++vb)
#pragma unroll
                for (int q4 = 0; q4 < 4; ++q4) { u32x2 w; w.x = pk2(o[vb][4 * q4] * inv, o[vb][4 * q4 + 1] * inv); w.y = pk2(o[vb][4 * q4 + 2] * inv, o[vb][4 * q4 + 3] * inv);
                    *(u32x2*)(op + 32 * vb + 8 * q4 + 4 * hi) = w; }
        }
    }
#undef AT_DMA
    for (int it = blockIdx.x; it < 256; it += G) {
        const int db = it >> 4, h = it & 15; const size_t kv0 = (size_t)MP + db * KSS;
        const size_t qrow = (size_t)MP + db * 16 + (l32 & 15);
        const LAS unsigned char* qs = lds + 66560;
        if (wave == 0) { const bf16x8 z8 = {0, 0, 0, 0, 0, 0, 0, 0};
#pragma unroll
            for (int ks = 0; ks < 8; ++ks) *(LAS bf16x8*)(lds + 66560 + ks * 1024 + lane * 16) = l32 < 16 ? *(const bf16x8*)(QN + qrow * 2048 + h * 128 + 16 * ks + 8 * hi) : z8;
#pragma unroll
            for (int ks = 0; ks < 4; ++ks) *(LAS bf16x8*)(lds + 66560 + (8 + ks) * 1024 + lane * 16) = l32 < 16 ? *(const bf16x8*)(QP + qrow * 1024 + h * 64 + 16 * ks + 8 * hi) : z8; }
        __syncthreads();
        float l = 0.f; f32x16 o[4] = {};
        for (int j = wave; j < 17; j += 8) {
            const size_t kr = kv0 + 64 * (size_t)j;
            const KFGlb kf{KN + (kr + l32) * 2048 + h * 128, KPE + (kr + l32) * 64, hi}; const VFGlb vf{VT + (size_t)(h * 128 + l32) * VTP + kr, hi};
            attn_tile_s(qs, lane, l, o, kf, vf, KSS - 64 * j, hi);
        }
        l += __shfl_xor(l, 32);
        LAS float* Mw = (LAS float*)lds; LAS float* Lw = Mw + 128; LAS float* Ow = Mw + 256;
        if (l32 < 16) { if (hi == 0) { Lw[wave * 16 + l32] = l; }
#pragma unroll
            for (int vb = 0; vb < 4; ++vb)
#pragma unroll
                for (int q4 = 0; q4 < 4; ++q4) *(LAS f32x4*)(Ow + (wave * 16 + l32) * 128 + 32 * vb + 8 * q4 + 4 * hi) = (f32x4){o[vb][4 * q4], o[vb][4 * q4 + 1], o[vb][4 * q4 + 2], o[vb][4 * q4 + 3]}; }
        __syncthreads();
        { const int q = tid >> 5, v4 = (tid & 31) * 4;
          float L = 0.f; f32x4 O = {0.f, 0.f, 0.f, 0.f};
#pragma unroll
          for (int w = 0; w < 8; ++w) { L += Lw[w * 16 + q]; O += *(const LAS f32x4*)(Ow + (w * 16 + q) * 128 + v4); }
          const float inv = 1.0f / L; u32x2 wv; wv.x = pk2(O[0] * inv, O[1] * inv); wv.y = pk2(O[2] * inv, O[3] * inv);
          *(u32x2*)(ATT + ((size_t)MP + db * 16 + q) * 4096 + h * 128 + v4) = wv; }
        __syncthreads();
    }
}
typedef float f32x2 __attribute__((ext_vector_type(2)));
__device__ __forceinline__ f32x2 gelu_pk(f32x2 v) {
    const f32x2 av = __builtin_elementwise_abs(v), d = av * 0.2316418882f + 1.0f;
    f32x2 t; t.x = __builtin_amdgcn_rcpf(d.x); t.y = __builtin_amdgcn_rcpf(d.y);
    f32x2 q = t * 0.5307027145f + (-0.7265760135f); q = q * t + 0.7107068705f; q = q * t + (-0.142248368f); q = q * t + 0.127414796f; q = q * t;
    const f32x2 s = (v * v) * (-0.72134752044f);
    f32x2 e; e.x = __builtin_amdgcn_exp2f(s.x); e.y = __builtin_amdgcn_exp2f(s.y);
    const f32x2 m = v * (q * e), r = v - m;
    f32x2 o; o.x = v.x < 0.f ? m.x : r.x; o.y = v.y < 0.f ? m.y : r.y; return o;
}
#define RLX_AGENT __ATOMIC_RELAXED, __HIP_MEMORY_SCOPE_AGENT
#define XB_TMO      128
#define XB_XCNT(j)  (256  + 64 * (j))
#define XB_XSUB(j)  (1280 + 64 * (j))
#define XB_XGEN(j)  (2304 + 64 * (j))
#define XB_TOP      3328
#define XB_TOPGEN   3392
#define XCD_BAR_WORDS 3456
#define XB_SPIN_CAP (1u << 18)

__device__ __forceinline__ unsigned xb_ld(unsigned* p)              { return __hip_atomic_load(p, __ATOMIC_RELAXED, __HIP_MEMORY_SCOPE_AGENT); }
__device__ __forceinline__ unsigned xb_add(unsigned* p, unsigned v) { return __hip_atomic_fetch_add(p, v, __ATOMIC_RELAXED, __HIP_MEMORY_SCOPE_AGENT); }
__device__ __forceinline__ unsigned xb_xcc_id() { return (unsigned)__builtin_amdgcn_s_getreg((3 << 11) | 20) & 0xFu; }
#define XB_SPIN(cond, bar) do { unsigned _sp = 0; while (cond) { __builtin_amdgcn_s_sleep(1); \
    if ((++_sp & 255u) == 0u) { if (xb_ld(&(bar)[XB_TMO])) break; if (_sp > XB_SPIN_CAP) { atomicAdd(&(bar)[XB_TMO], 1u); break; } } } } while (0)

struct XcdBarrier {
    unsigned* bar; unsigned x;
    volatile LAS unsigned* st;
};

__device__ __forceinline__ XcdBarrier xcd_barrier_post(unsigned* bar, volatile LAS unsigned* st) {
    XcdBarrier b; b.bar = bar; b.x = xb_xcc_id(); b.st = st;
    if (threadIdx.x == 0) (void)xb_add(&bar[XB_XCNT(b.x)], 1u);
    return b;
}
__device__ __forceinline__ void xcd_barrier_complete(unsigned* bar, unsigned x, unsigned& nloc, unsigned& nx) {
    const unsigned G = gridDim.x * gridDim.y * gridDim.z;
    unsigned sum, cnt, mine, sp = 0u;
    for (;;) {
        sum = 0u; cnt = 0u; mine = 0u;
#pragma unroll
        for (unsigned j = 0; j < 16; ++j) { const unsigned c = xb_ld(&bar[XB_XCNT(j)]); sum += c; cnt += (c > 0u) ? 1u : 0u; mine = (j == x) ? c : mine; }
        if (sum == G) break;
        __builtin_amdgcn_s_sleep(1);
        if ((++sp & 255u) == 0u) { if (xb_ld(&bar[XB_TMO])) break; if (sp > XB_SPIN_CAP) { atomicAdd(&bar[XB_TMO], 1u); break; } }
    }
    nloc = mine > 0u ? mine : 1u; nx = cnt > 0u ? cnt : 1u;
}

__device__ __forceinline__ void xcd_barrier(const XcdBarrier& b) {
    asm volatile("s_waitcnt vmcnt(0)" ::: "memory");
    __syncthreads();
    if (threadIdx.x == 0) {
        unsigned* bar = b.bar;
        __builtin_amdgcn_s_waitcnt(0);
        unsigned nloc = b.st[0], nx = b.st[1];
        if (nloc == 0u) { xcd_barrier_complete(bar, b.x, nloc, nx); b.st[0] = nloc; b.st[1] = nx; }
        const unsigned old = xb_add(&bar[XB_XSUB(b.x)], 1u);
        const unsigned gen = old / nloc;
        if (old + 1u == (gen + 1u) * nloc) {
            __builtin_amdgcn_fence(__ATOMIC_RELEASE, "agent");
            asm volatile("s_waitcnt vmcnt(0)" ::: "memory");
            const unsigned og = xb_add(&bar[XB_TOP], 1u);
            const unsigned tg = og / nx;
            if (og + 1u == (tg + 1u) * nx) xb_add(&bar[XB_TOPGEN], 1u);
            else XB_SPIN(xb_ld(&bar[XB_TOPGEN]) == tg, bar);
            __builtin_amdgcn_fence(__ATOMIC_ACQUIRE, "agent");
            xb_add(&bar[XB_XGEN(b.x)], 1u);
            asm volatile("s_waitcnt vmcnt(0)" ::: "memory");
        } else {
            XB_SPIN(xb_ld(&bar[XB_XGEN(b.x)]) == gen, bar);
            __builtin_amdgcn_fence(__ATOMIC_ACQUIRE, "agent");
            asm volatile("s_waitcnt vmcnt(0)" ::: "memory");
        }
    }
    __syncthreads();
}

#ifndef PH_MAX
#define PH_MAX 99
#endif
typedef const __attribute__((address_space(4))) Args* KArgP;
#define PH_BEGIN { KArgP ap_ = kap; asm volatile("" : "+s"(ap_)); const Args a = *ap_; unsigned char* ws = a.ws; \
    int tid_ = threadIdx.x; asm volatile("" : "+v"(tid_)); const int tid = tid_, lane = tid & 63, wave = __builtin_amdgcn_readfirstlane(tid >> 6), gw = bid * 8 + wave, NGW = G * 8; \
    LAS float* scr = (LAS float*)(lds + wave * 16384); LAS float* xs = (LAS float*)(lds + XS_OFF); const float* RT = (const float*)(ws + WS_ROPE); \
    (void)tid; (void)lane; (void)gw; (void)NGW; (void)scr; (void)xs; (void)RT;
#define PH_END }
__global__ void __launch_bounds__(512, 2) mega(Args a_unused) {
#if defined(__HIP_DEVICE_COMPILE__)
    extern __shared__ __attribute__((aligned(16))) unsigned char lds_raw[];
    LAS unsigned char* lds = (LAS unsigned char*)lds_raw;
    cg::grid_group grid = cg::this_grid();
    const int G = gridDim.x, bid = blockIdx.x;
    const KArgP kap = (KArgP)__builtin_amdgcn_kernarg_segment_ptr();
    volatile LAS unsigned* bst = (volatile LAS unsigned*)(lds + LDS_BYTES - 64);
    if (threadIdx.x < 2) bst[threadIdx.x] = 0u;
    __syncthreads();

    if (G == 0x7fffffff) grid.sync();
    XcdBarrier xbar;
    { KArgP ap_ = kap; asm volatile("" : "+s"(ap_)); xbar = xcd_barrier_post((unsigned*)(ap_->ws + WS_CTR), bst); }
    PH_BEGIN phase0(a, lds, G); PH_END
    xcd_barrier(xbar);
    PH_BEGIN {
        pg8::Gemm g{(const bf16_t*)(ws + WS_E), (const bf16_t*)(ws + WS_D), MA, NIN, 2048, 2048, 2048};
        pg8::StaticOrder S; S.init(MA, NIN, G, bid); EpiZ E{ws};
        pg8::gemm_phase<EpiZ, pg8::StaticOrder, true, true>(lds, g, S, E);
    } PH_END
    xcd_barrier(xbar);
    PH_BEGIN phase2(a, lds, G); PH_END
    xcd_barrier(xbar);
    PH_BEGIN {
        const int nscan = G / 2;
        if (bid >= nscan) {
            pg8::Gemm g{(const bf16_t*)(ws + WS_ZMQ), (const bf16_t*)(ws + WS_WUQ), MA, 3072, 512, 512, 512};
            pg8::StaticOrder S; S.init(MA, 3072, G - nscan, bid - nscan);
            EpiHead E{(bf16_t*)(ws + WS_E), 2048, a.in[16], 8, (bf16_t*)(ws + WS_D), 1024, a.in[18], RT, xs, ATT_C};
            pg8::gemm_phase<EpiHead, pg8::StaticOrder, true, true>(lds, g, S, E);
        }
    } PH_END
    PH_BEGIN { __syncthreads(); const int nscan = G / 2; gla_phase(a, lds, bid < nscan ? bid : 128, nscan); } PH_END
    xcd_barrier(xbar);
    PH_BEGIN {
        {
            pg8::Gemm g{(const bf16_t*)(ws + WS_CKVALL), (const bf16_t*)(ws + WS_WUKV), MKV, 2048, 512, 512, 512};
            pg8::StaticOrder S; S.init(MKV, 2048, G, bid);
            EpiHead E{(bf16_t*)(ws + WS_KN), 2048, a.in[17], 8, nullptr, 0, nullptr, RT, xs, 1.0f};
            pg8::gemm_phase<EpiHead, pg8::StaticOrder, true, true>(lds, g, S, E);
        }
        {
            pg8::Gemm g{(const bf16_t*)(ws + WS_WUKV) + (size_t)2048 * 512, (const bf16_t*)(ws + WS_CKVALL), 2048, MKV, 512, 512, 512};
            pg8::StaticOrder S; S.init(2048, MKV, G, (bid + G - 8) % G);
            EpiVT E{(bf16_t*)(ws + WS_VT)};
            pg8::gemm_phase<EpiVT, pg8::StaticOrder, true, true>(lds, g, S, E);
        }
        gla_norm(a, G);
    } PH_END
    xcd_barrier(xbar);
    PH_BEGIN {
        attention_phase(a, lds, G);
        __syncthreads();
    } PH_END
    PH_BEGIN {
        transpose_matrix_q(a.in[11], 2048, 2048, 2048, (bf16_t*)(ws + WS_WBR), 4096, 0, nullptr, ScId(), gw, NGW, lane);
        transpose_matrix_q(a.in[20], 2048, 2048, 2048, (bf16_t*)(ws + WS_WBR), 4096, 2048, nullptr, ScId(), gw, NGW, lane);
        transpose_matrix_q(a.in[21], 2048, 2048, 2048, (bf16_t*)(ws + WS_WOUT), 2048, 0, nullptr, ScId(), gw, NGW, lane);
    } PH_END
    xcd_barrier(xbar);
    PH_BEGIN {
        pg8::Gemm g{(const bf16_t*)(a.out + O_Y), (const bf16_t*)(ws + WS_WBR), MP, 2048, 4096, 4096, 4096};
        pg8::StaticOrder S; S.init(MP, 2048, G, bid);
        EpiMerge E{(const bf16_t*)(ws + WS_ZGA), (const bf16_t*)(ws + WS_ZGB), (bf16_t*)(ws + WS_MB)};
        pg8::gemm_phase<EpiMerge, pg8::StaticOrder, true, true>(lds, g, S, E);
    } PH_END
    PH_BEGIN {
        int ksz = 256; asm volatile("" : "+s"(ksz));
        pg8::Gemm g{(const bf16_t*)(a.out + O_Y), (const bf16_t*)(ws + WS_WBR), MA, 2048, ksz, 4096, 4096};
        pg8::SplitOrder S{MP / 256, 8, 16, 256, G, bid};
        EpiPart E{(float*)(ws + WS_TA)};
        pg8::gemm_phase<EpiPart, pg8::SplitOrder, true, true>(lds, g, S, E);
    } PH_END
    xcd_barrier(xbar);
    PH_BEGIN {
        const float* P = (const float*)(ws + WS_TA); const bf16_t* GA = (const bf16_t*)(ws + WS_ZGA) + (size_t)MP * DM; const bf16_t* GB = (const bf16_t*)(ws + WS_ZGB) + (size_t)MP * DM;
        bf16_t* MBs = (bf16_t*)(ws + WS_MB) + (size_t)MP * DM;
        for (int i = bid * 512 + tid; i < 256 * DM / 4; i += G * 512) { f32x4 sa = {0.f, 0.f, 0.f, 0.f}, sb = sa;
#pragma unroll
            for (int k = 0; k < 8; ++k) { sa += __builtin_nontemporal_load((const f32x4*)(P + (size_t)k * 256 * DM + 4 * (size_t)i)); sb += __builtin_nontemporal_load((const f32x4*)(P + (size_t)(8 + k) * 256 * DM + 4 * (size_t)i)); }
            const u32x2 ga = *(const u32x2*)(GA + 4 * (size_t)i), gb = *(const u32x2*)(GB + 4 * (size_t)i);
            u32x2 o; o.x = pk2(sa[0] * sigmoidf_(bflo(ga.x)) + sb[0] * sigmoidf_(bflo(gb.x)), sa[1] * sigmoidf_(bfhi(ga.x)) + sb[1] * sigmoidf_(bfhi(gb.x)));
            o.y = pk2(sa[2] * sigmoidf_(bflo(ga.y)) + sb[2] * sigmoidf_(bflo(gb.y)), sa[3] * sigmoidf_(bfhi(ga.y)) + sb[3] * sigmoidf_(bfhi(gb.y)));
            *(u32x2*)(MBs + 4 * (size_t)i) = o; }
    } PH_END
    xcd_barrier(xbar);
    PH_BEGIN {
        pg8::Gemm g{(const bf16_t*)(ws + WS_MB), (const bf16_t*)(ws + WS_WOUT), MP, 2048, 2048, 2048, 2048};
        pg8::StaticOrder S; S.init(MP, 2048, G, bid);
        EpiX1 E{a.in[0], a.in[1], a.out + O_Y, (bf16_t*)(ws + WS_E), (float*)(ws + WS_SUMSQ)};
        pg8::gemm_phase<EpiX1, pg8::StaticOrder, true, true>(lds, g, S, E);
    } PH_END
    PH_BEGIN {
        int ksz = 256; asm volatile("" : "+s"(ksz));
        pg8::Gemm g{(const bf16_t*)(ws + WS_MB), (const bf16_t*)(ws + WS_WOUT), MA, 2048, ksz, 2048, 2048};
        pg8::SplitOrder S{MP / 256, 8, 8, 256, G, bid};
        EpiPart E{(float*)(ws + WS_TA) + (size_t)16 * 256 * DM};
        pg8::gemm_phase<EpiPart, pg8::SplitOrder, true, true>(lds, g, S, E);
        __syncthreads();
        transpose_matrix_q(a.in[23], 2048, 2 * DFF, 2 * DFF, (bf16_t*)(ws + WS_WUP), 2048, 0, a.in[22], ScUp(), gw, NGW, lane);
    } PH_END
    xcd_barrier(xbar);
    PH_BEGIN {
        const float* P = (const float*)(ws + WS_TA) + (size_t)16 * 256 * DM; float* SS = (float*)(ws + WS_SUMSQ); bf16_t* X1B = (bf16_t*)(ws + WS_E);
        for (int r = gw; r < 256; r += NGW) { float ss = 0.f;
#pragma unroll
            for (int j = 0; j < 8; ++j) { const size_t o = (size_t)r * DM + 4 * lane + 256 * j; f32x4 v = *(const f32x4*)(a.in[1] + o);
#pragma unroll
                for (int k = 0; k < 8; ++k) v += __builtin_nontemporal_load((const f32x4*)(P + (size_t)k * 256 * DM + o));
                *(f32x4*)(a.out + O_Y + (size_t)MP * DM + o) = v;
                u32x2 w; w.x = pk2(v[0], v[1]); w.y = pk2(v[2], v[3]); *(u32x2*)(X1B + (size_t)MP * DM + o) = w;
                ss += (v[0] * v[0] + v[1] * v[1]) + (v[2] * v[2] + v[3] * v[3]); }
            ss = wave_sum(ss); if (lane == 0) SS[MP + r] = ss; }
    } PH_END
    xcd_barrier(xbar);
    PH_BEGIN {
        pg8::Gemm g{(const bf16_t*)(ws + WS_E), (const bf16_t*)(ws + WS_WUP), MA, 2 * DFF, 2048, 2048, 2048};
        pg8::StaticOrder S; S.init(MA, 2 * DFF, G, bid);
        EpiUpG E{(bf16_t*)(ws + WS_G), (const float*)(ws + WS_SUMSQ), a.out, a.in[24], a.in[25], a.in[5], (float*)(ws + WS_SIDE)};
        pg8::gemm_phase<EpiUpG, pg8::StaticOrder, true, true>(lds, g, S, E);
    } PH_END
    PH_BEGIN {
        const int rem = ((MA / 256) * (2 * DFF / 256)) % G, first = rem, nearly = G - rem;
        if (bid >= first) { const int nblk = 2048 / 32, nit = (DFF / 64) * nblk;
            for (int it = (bid - first) * 8 + wave; it < nit; it += nearly * 8) transpose_item_q(a.in[26], 2048, (bf16_t*)(ws + WS_WDOWN), DFF, 0, it / nblk, it % nblk, lane, nullptr, ScId()); }
    } PH_END
    xcd_barrier(xbar);
    PH_BEGIN {
        const float* AH = (const float*)(ws + WS_SIDE); const float* AF0 = AH + 33 * 8 * DFF; const float* GT0 = AH + 2 * 33 * 8 * DFF;
        const float* cw = a.in[24]; const float* cb = a.in[25]; bf16_t* Gb = (bf16_t*)(ws + WS_G);
        for (int i = bid * 512 + tid; i < 32 * 8 * DFF; i += G * 512) { const int c = i % DFF, q = i / DFF, rr = q & 1, pb = q >> 1, pm = pb >> 2, blk = pb & 3;
            const float a0 = AF0[((size_t)pb * 2 + rr) * DFF + c], gt = GT0[((size_t)pb * 2 + rr) * DFF + c];
            const bool start = blk == 0 && (pm == 0 || pm == TP / 256);
            const float h1 = start ? 0.f : AH[((size_t)(pb - 1) * 2 + 1) * DFF + c], h0 = start ? 0.f : AH[((size_t)(pb - 1) * 2) * DFF + c];
            const float a1 = rr == 0 ? h1 : AF0[((size_t)pb * 2) * DFF + c];
            const float a2 = rr == 0 ? h0 : h1;
            const float cv = cb[c] + cw[2 * DFF + c] * a0 + cw[DFF + c] * a1 + cw[c] * a2;
            f32x2 v2; v2.x = cv; v2.y = 0.f; const f32x2 ge = gelu_pk(v2);
            Gb[(size_t)(pm * 256 + blk * 64 + rr) * DFF + c] = (bf16_t)(pk2(ge.x * gt, 0.f) & 0xffffu); }
    } PH_END
    PH_BEGIN {
        int ksz = 256; asm volatile("" : "+s"(ksz));
        pg8::Gemm g{(const bf16_t*)(ws + WS_G), (const bf16_t*)(ws + WS_WDOWN), MA, 2048, ksz, DFF, DFF};
        pg8::SplitOrder S{MP / 256, 8, DFF / 256, 256, G, bid};
        EpiPart E{(float*)(ws + WS_PART)};
        __syncthreads();
        pg8::gemm_phase<EpiPart, pg8::SplitOrder, true, true>(lds, g, S, E);
    } PH_END
    xcd_barrier(xbar);
    PH_BEGIN {
        {
            const float* P = (const float*)(ws + WS_PART); float* Y = a.out + O_Y + (size_t)MP * DM;
            for (int i = bid * 512 + tid; i < 256 * DM / 4; i += G * 512) { f32x4 s = *(const f32x4*)(Y + 4 * (size_t)i);
#pragma unroll
                for (int k = 0; k < DFF / 256; ++k) s += __builtin_nontemporal_load((const f32x4*)(P + (size_t)k * 256 * DM + 4 * (size_t)i));
                *(f32x4*)(Y + 4 * (size_t)i) = s; }
        }
        {
            pg8::Gemm g{(const bf16_t*)(ws + WS_G), (const bf16_t*)(ws + WS_WDOWN), MP, 2048, DFF, DFF, DFF};
            pg8::StaticOrder S; S.init(MP, 2048, G, bid);
            EpiY E{a.out + O_Y};
            pg8::gemm_phase<EpiY, pg8::StaticOrder, true, true>(lds, g, S, E);
        }
    } PH_END
#endif
}

extern "C" void kernel_launch(void* const* d_in, const int* in_sizes, int n_in, void* d_out, int out_size, void* d_ws, size_t ws_size, hipStream_t stream) {
    static int grid = 0;
    if (grid == 0) {
        if (n_in != 27 || ws_size < WS_END || out_size != (int)O_END) { fprintf(stderr, "kernel_launch: unexpected problem: n_in %d ws %zu out %d\n", n_in, ws_size, out_size); grid = -1; return; }
        int dev = 0, cus = 0, per_cu = 0;
        (void)hipGetDevice(&dev); (void)hipDeviceGetAttribute(&cus, hipDeviceAttributeMultiprocessorCount, dev);
        (void)hipFuncSetAttribute((const void*)mega, hipFuncAttributeMaxDynamicSharedMemorySize, LDS_BYTES);
        (void)hipOccupancyMaxActiveBlocksPerMultiprocessor(&per_cu, (const void*)mega, 512, LDS_BYTES);
        if (per_cu < 1) { fprintf(stderr, "kernel_launch: occupancy query says %d blocks/CU\n", per_cu); grid = -1; return; }
        grid = cus;
    }
    if (grid < 0) return;
    if (hipMemsetAsync((unsigned char*)d_ws + WS_CTR, 0, 16384, stream) != hipSuccess) { fprintf(stderr, "kernel_launch: memset of the barrier words failed\n"); return; }
    Args a{};
    for (int i = 0; i < 27; ++i) a.in[i] = (const float*)d_in[i];
    a.out = (float*)d_out; a.ws = (unsigned char*)d_ws;
    void* args[] = {&a};
    hipError_t e = hipLaunchCooperativeKernel((const void*)mega, dim3(grid), dim3(512), args, LDS_BYTES, stream);
    if (e != hipSuccess) fprintf(stderr, "cooperative launch failed: %s (grid %d)\n", hipGetErrorString(e), grid);
}
```

```cpp
#include <hip/hip_runtime.h>
#include <hip/hip_cooperative_groups.h>
#include <cstdio>
#include <cstdint>
#include <cmath>
namespace cg = cooperative_groups;

namespace pg8 {
#define PG8_LAS __attribute__((address_space(3)))
typedef unsigned short bf16_t;
typedef short bf16x8 __attribute__((ext_vector_type(8)));
typedef float f32x4 __attribute__((ext_vector_type(4)));
typedef unsigned u32x4 __attribute__((ext_vector_type(4)));
constexpr int BM = 256, BK = 64, HALF = 128, HTB = HALF * BK * 2  , STAGE_BYTES = 8 * HTB, NXCD = 8, WGM = 8;

__host__ __device__ __forceinline__ int lds_byte(int r, int c) { const int st = (r >> 4) * 2 + (c >> 5), rr = r & 15, cc = c & 31, ob = rr * 64 + cc * 2; return st * 1024 + (ob ^ (((ob >> 9) & 1) << 5)); }
__host__ __device__ __forceinline__ void stage_rc(int b, int& R, int& C) { const int st = b / 1024, sb = b % 1024, swz = sb ^ (((sb >> 9) & 1) << 5); R = (st >> 1) * 16 + swz / 64; C = (st & 1) * 32 + (swz % 64) / 2; }
__host__ __device__ __forceinline__ int perm32(int rho) { const int n = rho >> 4, i = rho & 15; return 8 * (i >> 2) + 4 * n + (i & 3); }

struct Unit { int pm, pn, kofs; };
struct Gemm { const bf16_t* A; const bf16_t* Bt; int M, N, K, lda, ldb; };

struct StaticOrder {
    int nM, nN, nwg, G, c;
    __host__ __device__ void init(int M, int N, int G_, int c_) { nM = M / BM; nN = N / BM; nwg = nM * nN; G = G_; c = c_; }
    __host__ __device__ bool next(int i, Unit& u) const {
        const long L = (long)i * G + c; if (L >= nwg) return false;
        int wgid = (int)L; { const int q = nwg / NXCD, r = nwg % NXCD, xcd = wgid % NXCD, off = wgid / NXCD; wgid = (xcd < r ? xcd * (q + 1) : r * (q + 1) + (xcd - r) * q) + off; }
        const int nig = WGM * nN, gid = wgid / nig, fm = gid * WGM, gsz = (nM - fm) < WGM ? (nM - fm) : WGM;
        u.pm = fm + ((wgid % nig) % gsz); u.pn = (wgid % nig) / gsz; u.kofs = 0; return true;
    }
    __device__ __forceinline__ void a_ready(const Unit&) const {}
    __device__ __forceinline__ void done(const Unit&) const {}
};
struct SplitOrder {
    int pm, nN, nsplit, ksz, G, c;
    __device__ __forceinline__ bool next(int i, Unit& u) const { const int L = i * G + c; if (L >= nN * nsplit) return false; u.pm = pm; u.pn = L % nN; u.kofs = (L / nN) * ksz; return true; }
    __device__ __forceinline__ void a_ready(const Unit&) const {}
    __device__ __forceinline__ void done(const Unit&) const {}
};
__device__ __forceinline__ unsigned cvt_pk_bf16(float lo, float hi) { unsigned r; asm volatile("v_cvt_pk_bf16_f32 %0, %1, %2" : "=v"(r) : "v"(lo), "v"(hi)); return r; }

template <class Epi, class Sched, bool ALIGN_EPI = false, bool SP2 = false>
__device__ __forceinline__ void gemm_phase(PG8_LAS unsigned char* lds, const Gemm g, const Sched& S, const Epi& E) {
    int tid_ = threadIdx.x; asm volatile("" : "+v"(tid_)); const int tid = tid_, wid = __builtin_amdgcn_readfirstlane(tid >> 6), lane = tid & 63, wr = wid >> 2, wc = wid & 3, fr = lane & 15, fq = lane >> 4;
    const int K = g.K, nt = K / BK;
    unsigned voffA[2], voffB[2];
#pragma unroll
    for (int i = 0; i < 2; ++i) { int R, C; stage_rc(tid * 16 + i * 8192, R, C); const int Rb = Epi::PERM ? ((R & ~31) + perm32(R & 31)) : R;
        voffA[i] = (unsigned)(R * g.lda + C) * 2u; voffB[i] = (unsigned)(Rb * g.ldb + C) * 2u; }
    const size_t kstep = (size_t)(BK * 2);
    const size_t hstepA = (size_t)HALF * g.lda * 2, hstepB = (size_t)HALF * g.ldb * 2;
    const size_t tstepA = 2 * hstepA, tstepB = 2 * hstepB;
    const unsigned ldsw = (unsigned)wid * 1024u;
    const int aoff = lds_byte(wr * 64 + fr, fq * 8), boff = lds_byte(wc * 32 + fr, fq * 8);
#define PG8_SA(b, h) (((b) * 2 + (h)) * HTB)
#define PG8_SB(b, h) ((4 + (b) * 2 + (h)) * HTB)
#define PG8_STAGE(bufoff, gbase, voff) do { _Pragma("unroll") for (int _i = 0; _i < 2; ++_i) \
        __builtin_amdgcn_global_load_lds((const unsigned*)((const char*)(gbase) + (voff)[_i]), (PG8_LAS unsigned*)(lds + (bufoff) + ldsw + _i * 8192), 16, 0, 0); } while (0)
#define PG8_LDA(dst, b, h) do { _Pragma("unroll") for (int m = 0; m < 4; ++m) _Pragma("unroll") for (int k = 0; k < 2; ++k) dst[m][k] = *(const PG8_LAS bf16x8*)(lds + PG8_SA(b, h) + aoff + m * 2048 + k * 1024); } while (0)
#define PG8_LDB(dst, b, h) do { _Pragma("unroll") for (int n = 0; n < 2; ++n) _Pragma("unroll") for (int k = 0; k < 2; ++k) dst[n][k] = *(const PG8_LAS bf16x8*)(lds + PG8_SB(b, h) + boff + n * 2048 + k * 1024); } while (0)
#define PG8_MMA(ai, bj, At, Bt) do { __builtin_amdgcn_s_setprio(1); _Pragma("unroll") for (int m = 0; m < 4; ++m) _Pragma("unroll") for (int n = 0; n < 2; ++n) _Pragma("unroll") for (int k = 0; k < 2; ++k) \
        acc[ai][bj][m][n] = __builtin_amdgcn_mfma_f32_16x16x32_bf16(Bt[n][k], At[m][k], acc[ai][bj][m][n], 0, 0, 0); __builtin_amdgcn_s_setprio(0); } while (0)
#define PG8_WAIT_V(n) asm volatile("s_waitcnt vmcnt(" #n ")" ::: "memory")
#define PG8_WAIT_L(n) asm volatile("s_waitcnt lgkmcnt(" #n ")" ::: "memory")
#define PG8_BAR __builtin_amdgcn_s_barrier()
#define PG8_SCHED __builtin_amdgcn_sched_barrier(0)
    Unit cur, nxt; int ui = 0;
    if (!S.next(0, cur)) return;
    f32x4 acc[2][2][4][2];
#pragma unroll
    for (int a = 0; a < 2; ++a)
#pragma unroll
        for (int b = 0; b < 2; ++b)
#pragma unroll
            for (int m = 0; m < 4; ++m)
#pragma unroll
                for (int n = 0; n < 2; ++n) acc[a][b][m][n] = (f32x4){0.f, 0.f, 0.f, 0.f};
    bf16x8 At[4][2], B0[2][2], B1[2][2];
    const char* cA = (const char*)g.A + (size_t)cur.pm * tstepA + (size_t)cur.kofs * 2; const char* cB = (const char*)g.Bt + (size_t)cur.pn * tstepB + (size_t)cur.kofs * 2;
    S.a_ready(cur);
    if constexpr (SP2) {
        PG8_STAGE(PG8_SB(0, 0), cB, voffB); PG8_STAGE(PG8_SB(0, 1), cB + hstepB, voffB); PG8_STAGE(PG8_SA(0, 0), cA, voffA); PG8_STAGE(PG8_SA(0, 1), cA + hstepA, voffA);
        if (wr == 1) PG8_BAR;
        PG8_WAIT_V(2); PG8_BAR;
        PG8_STAGE(PG8_SB(1, 0), cB + kstep, voffB); PG8_STAGE(PG8_SA(1, 0), cA + kstep, voffA); PG8_STAGE(PG8_SB(1, 1), cB + hstepB + kstep, voffB);
        PG8_WAIT_V(6); PG8_BAR;
    } else {
        PG8_STAGE(PG8_SB(0, 0), cB, voffB); PG8_STAGE(PG8_SA(0, 0), cA, voffA); PG8_STAGE(PG8_SB(0, 1), cB + hstepB, voffB); PG8_STAGE(PG8_SA(0, 1), cA + hstepA, voffA);
        if (wr == 1) PG8_BAR;
        PG8_WAIT_V(4); PG8_BAR;
        PG8_STAGE(PG8_SB(1, 0), cB + kstep, voffB); PG8_STAGE(PG8_SA(1, 0), cA + kstep, voffA); PG8_STAGE(PG8_SB(1, 1), cB + hstepB + kstep, voffB);
        PG8_WAIT_V(6); PG8_BAR;
    }
    for (;;) {
        const bool has_next = S.next(ui + 1, nxt);
        const char* nA = has_next ? (const char*)g.A + (size_t)nxt.pm * tstepA + (size_t)nxt.kofs * 2 : cA; const char* nB = has_next ? (const char*)g.Bt + (size_t)nxt.pn * tstepB + (size_t)nxt.kofs * 2 : cB;
        for (int t = 0; t < nt; t += 2) {
            if constexpr (Epi::HAS_MID) { if (t == (nt >> 1)) E.mid(acc, cur, wr, wc, fr, fq); }
            const bool last = (t == nt - 2);
            const char* a1 = cA + (size_t)(t + 1) * kstep;
            const char* a2 = last ? nA : cA + (size_t)(t + 2) * kstep; const char* b2 = last ? nB : cB + (size_t)(t + 2) * kstep;
            const char* a3 = a2 + kstep; const char* b3 = b2 + kstep;
            if (last && has_next) S.a_ready(nxt);
            if constexpr (SP2) {
            PG8_LDB(B0, 0, 0); PG8_LDB(B1, 0, 1); PG8_SCHED; PG8_LDA(At, 0, 0); PG8_STAGE(PG8_SA(1, 1), a1 + hstepA, voffA);
            PG8_WAIT_V(8); PG8_WAIT_L(0); PG8_BAR; PG8_MMA(0, 0, At, B0); PG8_MMA(0, 1, At, B1); PG8_BAR; PG8_SCHED;
            PG8_LDA(At, 0, 1); PG8_STAGE(PG8_SB(0, 0), b2, voffB); PG8_STAGE(PG8_SB(0, 1), b2 + hstepB, voffB); PG8_STAGE(PG8_SA(0, 0), a2, voffA);
            PG8_WAIT_V(8); PG8_WAIT_L(0); PG8_BAR; PG8_MMA(1, 0, At, B0); PG8_MMA(1, 1, At, B1); PG8_BAR; PG8_SCHED;
            PG8_LDB(B0, 1, 0); PG8_LDB(B1, 1, 1); PG8_SCHED; PG8_LDA(At, 1, 0); PG8_STAGE(PG8_SA(0, 1), a2 + hstepA, voffA);
            PG8_WAIT_V(8); PG8_WAIT_L(0); PG8_BAR; PG8_MMA(0, 0, At, B0); PG8_MMA(0, 1, At, B1); PG8_BAR; PG8_SCHED;
            PG8_LDA(At, 1, 1); PG8_STAGE(PG8_SB(1, 0), b3, voffB); PG8_STAGE(PG8_SB(1, 1), b3 + hstepB, voffB); PG8_STAGE(PG8_SA(1, 0), a3, voffA);
            PG8_WAIT_V(8); PG8_WAIT_L(0); PG8_BAR; PG8_MMA(1, 0, At, B0); PG8_MMA(1, 1, At, B1); PG8_BAR; PG8_SCHED;
            } else {
            PG8_LDB(B0, 0, 0); PG8_SCHED; PG8_LDA(At, 0, 0); PG8_STAGE(PG8_SA(1, 1), a1 + hstepA, voffA);
            PG8_WAIT_L(8); PG8_BAR; PG8_WAIT_L(0); PG8_MMA(0, 0, At, B0); PG8_BAR; PG8_SCHED;
            PG8_LDB(B1, 0, 1); PG8_STAGE(PG8_SB(0, 0), b2, voffB);
            PG8_BAR; PG8_WAIT_L(0); PG8_MMA(0, 1, At, B1); PG8_BAR;
            PG8_LDA(At, 0, 1); PG8_STAGE(PG8_SA(0, 0), a2, voffA);
            PG8_BAR; PG8_WAIT_L(0); PG8_MMA(1, 0, At, B0); PG8_BAR; PG8_SCHED;
            PG8_STAGE(PG8_SB(0, 1), b2 + hstepB, voffB);
            PG8_WAIT_V(6); PG8_BAR; PG8_MMA(1, 1, At, B1); PG8_BAR;
            PG8_LDB(B0, 1, 0); PG8_SCHED; PG8_LDA(At, 1, 0); PG8_STAGE(PG8_SA(0, 1), a2 + hstepA, voffA);
            PG8_WAIT_L(8); PG8_BAR; PG8_WAIT_L(0); PG8_MMA(0, 0, At, B0); PG8_BAR; PG8_SCHED;
            PG8_LDB(B1, 1, 1); PG8_STAGE(PG8_SB(1, 0), b3, voffB);
            PG8_BAR; PG8_WAIT_L(0); PG8_MMA(0, 1, At, B1); PG8_BAR;
            PG8_LDA(At, 1, 1); PG8_STAGE(PG8_SA(1, 0), a3, voffA);
            PG8_BAR; PG8_WAIT_L(0); PG8_MMA(1, 0, At, B0); PG8_BAR; PG8_SCHED;
            PG8_STAGE(PG8_SB(1, 1), b3 + hstepB, voffB);
            PG8_WAIT_V(6); PG8_BAR; PG8_MMA(1, 1, At, B1); PG8_BAR;
            }
        }
        if constexpr (ALIGN_EPI) { if (wr == 0) PG8_BAR; }
        if constexpr (!Epi::AFTER_DRAIN) { E(acc, cur, wr, wc, fr, fq); S.done(cur); }
        if (!has_next) break;
#pragma unroll
        for (int a = 0; a < 2; ++a)
#pragma unroll
            for (int b = 0; b < 2; ++b)
#pragma unroll
                for (int m = 0; m < 4; ++m)
#pragma unroll
                    for (int n = 0; n < 2; ++n) acc[a][b][m][n] = (f32x4){0.f, 0.f, 0.f, 0.f};
        cur = nxt; cA = nA; cB = nB; ++ui;
        if constexpr (ALIGN_EPI) { if (wr == 1) PG8_BAR; }
    }
    PG8_WAIT_V(0);
    if constexpr (!ALIGN_EPI) { if (wr == 0) PG8_BAR; }
    PG8_BAR;
    if constexpr (Epi::AFTER_DRAIN) { E.fused(acc, cur, wr, wc, fr, fq, lds, wid, lane); S.done(cur); }
#undef PG8_SA
#undef PG8_SB
#undef PG8_STAGE
#undef PG8_LDA
#undef PG8_LDB
#undef PG8_MMA
#undef PG8_WAIT_V
#undef PG8_WAIT_L
#undef PG8_BAR
#undef PG8_SCHED
}
}

#define LAS __attribute__((address_space(3)))
typedef unsigned short bf16_t;
typedef short bf16x8 __attribute__((ext_vector_type(8)));
typedef float f32x4 __attribute__((ext_vector_type(4)));
typedef float f32x16 __attribute__((ext_vector_type(16)));
typedef unsigned u32x4 __attribute__((ext_vector_type(4)));
typedef unsigned u32x2 __attribute__((ext_vector_type(2)));

constexpr int DM = 2048, TP = 4096, MP = 8192, DBS = 16, DTS = 16, MA = 8448;
constexpr int PAST = 1024, KSS = 1040;
constexpr int MKV = MP + DBS * KSS;
constexpr int MKVP = MKV + 64;
constexpr int DFF = 5632, NIN = 11520, NCH = 144;
constexpr float EPS = 1e-6f;
constexpr int LDS_BYTES = 163840;
constexpr int XS_OFF = 131072;

constexpr size_t WS_SUMSQ = 0, WS_CTR = 40960, WS_EBL = 65536, WS_ROPE = 1048576;
constexpr size_t WS_WUQ = 2097152, WS_WUKV = 5242880, WS_CKVALL = 9437184, WS_KPEALL = 34930688;
constexpr size_t WS_E = 38117376;
constexpr size_t WS_ZV = 72720384, WS_ZR = 107323392, WS_ZGA = 141926400, WS_ZGB = 176529408;
constexpr size_t WS_D = 211132416;
constexpr size_t WS_ZQ = 258318336, WS_ZK = 275619840, WS_ZMQ = 292921344, WS_ZMKV = 301572096, WS_ZMISC = 310222848;
constexpr size_t WS_ZKT = 314548224, WS_AF = 331849728;
constexpr size_t WS_KN = 228433920, WS_VT = 330407936;
constexpr size_t WS_WBR = WS_ZV, WS_WOUT = WS_ZV + 16777216, WS_MB = WS_ZR;
constexpr size_t WS_TA = WS_KN;
constexpr size_t WS_WUP = 368561664, WS_WDOWN = 414699008, WS_END = 437767680;
constexpr size_t WS_U = WS_ZV, WS_G = 263036928, WS_SIDE = WS_ZV, WS_PART = WS_ZV + 33554432;
constexpr int VTP = MKVP;
constexpr size_t O_Y = 0, O_ST = 17301504, O_CKV = 26738688, O_KPE = 31064064, O_FCP = 31604736, O_FCS = 31627264, O_END = 31807488;

struct Args { const float* in[27]; float* out; unsigned char* ws; };

__device__ __forceinline__ unsigned pk2(float lo, float hi) { return pg8::cvt_pk_bf16(lo, hi); }
__device__ __forceinline__ float bf2f(unsigned short b) { return __uint_as_float((unsigned)b << 16); }
__device__ __forceinline__ float bflo(unsigned w) { return __uint_as_float(w << 16); }
__device__ __forceinline__ float bfhi(unsigned w) { return __uint_as_float(w & 0xffff0000u); }
__device__ __forceinline__ float wave_sum(float v) {
#pragma unroll
    for (int o = 1; o < 64; o <<= 1) v += __shfl_xor(v, o);
    return v;
}
#define LDS_WAIT() asm volatile("s_waitcnt lgkmcnt(0)" ::: "memory")
__device__ __forceinline__ void unpack8(const u32x4 w, float (&x)[8]) { x[0] = bflo(w.x); x[1] = bfhi(w.x); x[2] = bflo(w.y); x[3] = bfhi(w.y); x[4] = bflo(w.z); x[5] = bfhi(w.z); x[6] = bflo(w.w); x[7] = bfhi(w.w); }

struct ScId { __device__ __forceinline__ int operator()(int d) const { return d; } };
struct ScIn { __device__ __forceinline__ int operator()(int d) const {
    if (d < 4096) return d;
    if (d < 6144) return 4112 + (d - 4096);
    if (d < 8192) return 7248 + (d - 6144);
    if (d < 10240) return 9296 + (d - 8192);
    if (d < 10752) return 6160 + (d - 10240);
    if (d < 11264) return 6672 + (d - 10752);
    if (d < 11328) return 7184 + (d - 11264);
    if (d < 11344) return 4096 + (d - 11328);
    return -1; } };
struct ScUq { __device__ __forceinline__ int operator()(int d) const {
    if (d < 2048) return (d >> 7) * 192 + (d & 127);
    d -= 2048; const int h = d >> 6, p = d & 63; return h * 192 + 128 + (p & 1) * 32 + (p >> 1); } };
struct ScUkv { __device__ __forceinline__ int operator()(int d) const {
    if (d < 2048) return (d >> 7) * 256 + (d & 127);
    d -= 2048; return (d >> 7) * 256 + 128 + (d & 127); } };

struct ScUp { __device__ __forceinline__ int operator()(int d) const { const int pn = d >> 8, c = d & 255; return c < 128 ? pn * 128 + c : 5632 + pn * 128 + (c - 128); } };
template <class SC>
__device__ __forceinline__ void transpose_item(const float* __restrict__ W, int Nsrc, bf16_t* __restrict__ WT, int ldt, int koff, LAS float* scr, int kb, int nb, int lane, const float* __restrict__ kscale, SC sc) {
    const int k0 = 64 * kb, n0 = 32 * nb;
    const int scl = sc(n0 + (lane & 31));
#pragma unroll 8
    for (int i = 0; i < 32; ++i) { const int kk = 2 * i + (lane >> 5); float v = scl >= 0 ? __builtin_nontemporal_load(W + (size_t)(k0 + kk) * Nsrc + scl) : 0.f; if (kscale) v *= kscale[k0 + kk]; scr[kk * 33 + (lane & 31)] = v; }
    LDS_WAIT();
    const int c = lane & 7;
#pragma unroll
    for (int j = 0; j < 4; ++j) { const int n = (lane >> 3) + 8 * j; const LAS float* s = scr + (8 * c) * 33 + n;
        u32x4 o; o.x = pk2(s[0 * 33], s[1 * 33]); o.y = pk2(s[2 * 33], s[3 * 33]); o.z = pk2(s[4 * 33], s[5 * 33]); o.w = pk2(s[6 * 33], s[7 * 33]);
        *(u32x4*)(WT + (size_t)(n0 + n) * ldt + koff + k0 + 8 * c) = o; }
    LDS_WAIT();
}
template <class SC>
__device__ __forceinline__ void transpose_item_q(const float* __restrict__ W, int Nsrc, bf16_t* __restrict__ WT, int ldt, int koff, int kb, int nb, int lane, const float* __restrict__ kscale, SC sc) {
    const int nq = lane & 7, ko = lane >> 3, k0 = 64 * kb + 8 * ko, n0 = 32 * nb + 4 * nq;
    const int scl = sc(n0);
    f32x4 v[8];
#pragma unroll
    for (int i = 0; i < 8; ++i) v[i] = scl >= 0 ? __builtin_nontemporal_load((const f32x4*)(W + (size_t)(k0 + i) * Nsrc + scl)) : (f32x4){0.f, 0.f, 0.f, 0.f};
    if (kscale) { const f32x4 s0 = *(const f32x4*)(kscale + k0), s1 = *(const f32x4*)(kscale + k0 + 4);
#pragma unroll
        for (int i = 0; i < 4; ++i) { v[i] = v[i] * s0[i]; v[4 + i] = v[4 + i] * s1[i]; } }
#pragma unroll
    for (int j = 0; j < 4; ++j) { u32x4 o; o.x = pk2(v[0][j], v[1][j]); o.y = pk2(v[2][j], v[3][j]); o.z = pk2(v[4][j], v[5][j]); o.w = pk2(v[6][j], v[7][j]);
        *(u32x4*)(WT + (size_t)(n0 + j) * ldt + koff + k0) = o; }
}
template <class SC>
__device__ __forceinline__ void transpose_matrix_q(const float* W, int K, int Nsrc, int Ndst, bf16_t* WT, int ldt, int koff, const float* kscale, SC sc, int gw, int NGW, int lane) {
    const int nblk = Ndst / 32, nit = (K / 64) * nblk;
    for (int it = gw; it < nit; it += NGW) transpose_item_q(W, Nsrc, WT, ldt, koff, it / nblk, it % nblk, lane, kscale, sc);
}
template <class SC>
__device__ __forceinline__ void transpose_matrix(const float* W, int K, int Nsrc, int Ndst, bf16_t* WT, int ldt, int koff, const float* kscale, SC sc, LAS float* scr, int gw, int NGW, int lane) {
    const int nblk = Ndst / 32, nit = (K / 64) * nblk;
    for (int it = gw; it < nit; it += NGW) transpose_item(W, Nsrc, WT, ldt, koff, scr, it / nblk, it % nblk, lane, kscale, sc);
}

struct EpiZ {
    static constexpr bool PERM = true, AFTER_DRAIN = false, HAS_MID = false;
    unsigned char* ws;
    __device__ __forceinline__ void operator()(const pg8::f32x4 (&acc)[2][2][4][2], const pg8::Unit& u, int wr, int wc, int fr, int fq) const {
        const int pn = u.pn; size_t off; int ld, c0;
        if (pn < 4) { off = WS_ZQ; ld = 1024; c0 = pn * 256; }
        else if (pn < 8) { off = WS_ZK; ld = 1024; c0 = (pn - 4) * 256; }
        else if (pn < 16) { off = WS_ZV; ld = 2048; c0 = (pn - 8) * 256; }
        else if (pn < 24) { off = WS_ZR; ld = 2048; c0 = (pn - 16) * 256; }
        else if (pn < 32) { off = WS_ZGA; ld = 2048; c0 = (pn - 24) * 256; }
        else if (pn < 40) { off = WS_ZGB; ld = 2048; c0 = (pn - 32) * 256; }
        else if (pn < 42) { off = WS_ZMQ; ld = 512; c0 = (pn - 40) * 256; }
        else if (pn < 44) { off = WS_ZMKV; ld = 512; c0 = (pn - 42) * 256; }
        else { off = WS_ZMISC; ld = 256; c0 = 0; }
        bf16_t* base = (bf16_t*)(ws + off);
        const int row0 = u.pm * 256 + wr * 64 + fr, col0 = c0 + wc * 32 + 8 * fq;
#pragma unroll
        for (int ai = 0; ai < 2; ++ai)
#pragma unroll
            for (int m = 0; m < 4; ++m) { bf16_t* rowp = base + (size_t)(row0 + ai * 128 + m * 16) * ld + col0;
#pragma unroll
                for (int bj = 0; bj < 2; ++bj) { const pg8::f32x4 v0 = acc[ai][bj][m][0], v1 = acc[ai][bj][m][1];
                    u32x4 w; w.x = pk2(v0[0], v0[1]); w.y = pk2(v0[2], v0[3]); w.z = pk2(v1[0], v1[1]); w.w = pk2(v1[2], v1[3]);
                    *(u32x4*)(rowp + bj * 128) = w; } }
    }
};

__device__ __forceinline__ int kvrow(int m) { return m < MP ? m : MP + ((m - MP) >> 4) * KSS + PAST + ((m - MP) & 15); }
__device__ __forceinline__ int tokpos(int m) { return m < MP ? (m & (TP - 1)) : PAST + ((m - MP) & 15); }

__device__ __forceinline__ void phase0(const Args& a, LAS unsigned char* lds, int G) {
    int tid_ = threadIdx.x; asm volatile("" : "+v"(tid_)); const int tid = tid_, lane = tid & 63, wave = __builtin_amdgcn_readfirstlane(tid >> 6);
    const int gw = blockIdx.x * 8 + wave, NGW = G * 8;
    LAS float* scr = (LAS float*)(lds + wave * 16384);
    unsigned char* ws = a.ws;
    transpose_matrix_q(a.in[6], 2048, 11344, NIN, (bf16_t*)(ws + WS_D), 2048, 0, nullptr, ScIn(), gw, NGW, lane);
    transpose_matrix(a.in[13], 512, 3072, 3072, (bf16_t*)(ws + WS_WUQ), 512, 0, nullptr, ScUq(), scr, gw, NGW, lane);
    transpose_matrix_q(a.in[15], 512, 4096, 4096, (bf16_t*)(ws + WS_WUKV), 512, 0, nullptr, ScUkv(), gw, NGW, lane);
    {
        const float* g1 = a.in[7]; bf16_t* H1 = (bf16_t*)(ws + WS_E);
        for (int m = gw; m < MA; m += NGW) {
            const float* xr = m < MP ? a.in[0] + (size_t)m * DM : a.in[1] + (size_t)(m - MP) * DM;
            f32x4 v[8]; float ss = 0.f;
#pragma unroll
            for (int j = 0; j < 8; ++j) { v[j] = __builtin_nontemporal_load((const f32x4*)(xr + 4 * lane + 256 * j)); ss += (v[j].x * v[j].x + v[j].y * v[j].y) + (v[j].z * v[j].z + v[j].w * v[j].w); }
            ss = wave_sum(ss); const float rstd = 1.0f / sqrtf(ss * (1.f / 2048.f) + EPS);
            bf16_t* o = H1 + (size_t)m * DM;
#pragma unroll
            for (int j = 0; j < 8; ++j) { const f32x4 g = *(const f32x4*)(g1 + 4 * lane + 256 * j);
                u32x2 w; w.x = pk2(v[j].x * rstd * g.x, v[j].y * rstd * g.y); w.y = pk2(v[j].z * rstd * g.z, v[j].w * rstd * g.w);
                *(u32x2*)(o + 4 * lane + 256 * j) = w; }
        }
    }
    {
        bf16_t* CK = (bf16_t*)(ws + WS_CKVALL); bf16_t* KP = (bf16_t*)(ws + WS_KPEALL);
        for (int r = gw; r < DBS * PAST; r += NGW) {
            const int db = r >> 10, p = r & 1023; const size_t row = (size_t)MP + db * KSS + p;
            const float* src = a.in[3] + (size_t)r * 512 + 8 * lane;
            const f32x4 x0 = __builtin_nontemporal_load((const f32x4*)src), x1 = __builtin_nontemporal_load((const f32x4*)(src + 4));
            u32x4 w; w.x = pk2(x0.x, x0.y); w.y = pk2(x0.z, x0.w); w.z = pk2(x1.x, x1.y); w.w = pk2(x1.z, x1.w);
            *(u32x4*)(CK + row * 512 + 8 * lane) = w;
            if (lane < 32) { const float* ks = a.in[4] + (size_t)r * 64; *(unsigned*)(KP + row * 64 + 2 * lane) = pk2(ks[lane], ks[32 + lane]); }
        }
    }
    {
        float* RT = (float*)(ws + WS_ROPE); const int gt = blockIdx.x * 512 + tid, NT = G * 512;
        for (int idx = gt; idx < 4096 * 32; idx += NT) { const int pos = idx >> 5, i = idx & 31;
            const float inv = exp2f(-(float)(2 * i) * (1.f / 64.f) * 13.287712379549449f);
            const float ang = (float)pos * inv; double rev = (double)ang * 0.15915494309189535; rev -= floor(rev); const float rv = (float)rev;
            RT[2 * idx] = __builtin_amdgcn_cosf(rv); RT[2 * idx + 1] = __builtin_amdgcn_sinf(rv); }
        float* SS = (float*)(ws + WS_SUMSQ);
        for (int i = gt; i < MA; i += NT) SS[i] = 0.f;
    }
}

__device__ __forceinline__ int crow(int r, int hi) { return (r & 3) + 8 * (r >> 2) + 4 * hi; }

__device__ __forceinline__ void phase2(const Args& a, LAS unsigned char* lds, int G) {
    int tid_ = threadIdx.x; asm volatile("" : "+v"(tid_)); const int tid = tid_, lane = tid & 63, wave = __builtin_amdgcn_readfirstlane(tid >> 6);
    unsigned char* ws = a.ws;
    bf16_t* ZQ = (bf16_t*)(ws + WS_ZQ); bf16_t* ZK = (bf16_t*)(ws + WS_ZK); bf16_t* ZMISC = (bf16_t*)(ws + WS_ZMISC);
    {
        LAS bf16_t* Qs = (LAS bf16_t*)lds; LAS bf16_t* Ks = (LAS bf16_t*)(lds + 66560);
        const float* w2 = a.in[8]; const float* bgp = a.in[9]; float* EBL = (float*)(ws + WS_EBL);
        bf16_t* ZKT = (bf16_t*)(ws + WS_ZKT); bf16_t* AF = (bf16_t*)(ws + WS_AF);
        for (int it = blockIdx.x; it < NCH * 2; it += G) {
            const int ci = it >> 1, half = it & 1, nrows = ci < 128 ? 64 : 16, row0 = ci < 128 ? ci * 64 : MP + (ci - 128) * 16;
            const int d = half * 512 + tid;
            float w2c[16];
#pragma unroll
            for (int r = 0; r < 16; ++r) w2c[r] = w2[r * 1024 + d];
            const float bg = bgp[d]; float b = 0.f;
#pragma unroll 8
            for (int t = 0; t < 64; ++t) {
                float qv = 0.f, kv = 0.f;
                if (t < nrows) {
                    const bf16_t* zm = ZMISC + (size_t)(row0 + t) * 256 + 64;
                    const u32x4 l0 = *(const u32x4*)zm, l1 = *(const u32x4*)(zm + 8);
                    float x = bg;
                    x += bflo(l0.x) * w2c[0] + bfhi(l0.x) * w2c[1] + bflo(l0.y) * w2c[2] + bfhi(l0.y) * w2c[3];
                    x += bflo(l0.z) * w2c[4] + bfhi(l0.z) * w2c[5] + bflo(l0.w) * w2c[6] + bfhi(l0.w) * w2c[7];
                    x += bflo(l1.x) * w2c[8] + bfhi(l1.x) * w2c[9] + bflo(l1.y) * w2c[10] + bfhi(l1.y) * w2c[11];
                    x += bflo(l1.z) * w2c[12] + bfhi(l1.z) * w2c[13] + bflo(l1.w) * w2c[14] + bfhi(l1.w) * w2c[15];
                    const float xc = fminf(fmaxf(x, -60.f), 60.f);
                    const float la2 = -__builtin_amdgcn_logf(1.0f + __builtin_amdgcn_exp2f(-xc * 1.4426950408889634f)) * 0.0625f;
                    b += la2; const float e = __builtin_amdgcn_exp2f(b), ei = __builtin_amdgcn_exp2f(-b);
                    const size_t o = (size_t)(row0 + t) * 1024 + d;
                    qv = bf2f(ZQ[o]) * 0.0625f * e; kv = bf2f(ZK[o]) * ei;
                }
                Qs[t * 520 + tid] = (bf16_t)(pk2(qv, 0.f) & 0xffffu); Ks[t * 520 + tid] = (bf16_t)(pk2(kv, 0.f) & 0xffffu);
            }
            EBL[ci * 1024 + d] = __builtin_amdgcn_exp2f(b);
            __syncthreads();
            if (wave < 6) {
                const int hh = wave / 3, tl = wave - 3 * hh, sb = tl == 2 ? 1 : 0, tb = tl == 0 ? 0 : 1, l32 = lane & 31, hi = lane >> 5;
                f32x16 acc = {};
                const LAS bf16_t* kp = Ks + (32 * sb + l32) * 520 + hh * 256 + 8 * hi; const LAS bf16_t* qp = Qs + (32 * tb + l32) * 520 + hh * 256 + 8 * hi;
#pragma unroll
                for (int ks = 0; ks < 16; ++ks) { const bf16x8 af = *(const LAS bf16x8*)(kp + 16 * ks), bfr = *(const LAS bf16x8*)(qp + 16 * ks);
                    acc = __builtin_amdgcn_mfma_f32_32x32x16_bf16(af, bfr, acc, 0, 0, 0); }
                unsigned w[8];
#pragma unroll
                for (int r = 0; r < 16; r += 2) { float v0 = acc[r], v1 = acc[r + 1];
                    if (tl != 1) { if (crow(r, hi) > l32) v0 = 0.f; if (crow(r + 1, hi) > l32) v1 = 0.f; }
                    w[r >> 1] = pk2(v0, v1); }
                bf16_t* dst = AF + ((size_t)((ci * 4 + 2 * half + hh) * 3 + tl) * 64 + lane) * 16;
                *(u32x4*)dst = (u32x4){w[0], w[1], w[2], w[3]}; *(u32x4*)(dst + 8) = (u32x4){w[4], w[5], w[6], w[7]};
            }
#pragma unroll
            for (int i = 0; i < 8; ++i) { const int c = tid + 512 * i, row = c >> 6, cc = c & 63, gi = cc >> 1, hi = cc & 1;
                if (row < nrows) { const LAS bf16_t* s = Qs + row * 520 + 16 * gi + 4 * hi;
                    const u32x2 lo = *(const LAS u32x2*)s, hi2 = *(const LAS u32x2*)(s + 8);
                    *(u32x4*)(ZQ + (size_t)(row0 + row) * 1024 + half * 512 + 8 * cc) = (u32x4){lo.x, lo.y, hi2.x, hi2.y}; } }
            for (int tg = 0; tg < nrows / 8; ++tg) { unsigned w[4];
#pragma unroll
                for (int j = 0; j < 4; ++j) w[j] = (unsigned)Ks[(8 * tg + 2 * j) * 520 + tid] | ((unsigned)Ks[(8 * tg + 2 * j + 1) * 520 + tid] << 16);
                *(u32x4*)(ZKT + (size_t)d * MA + row0 + 8 * tg) = (u32x4){w[0], w[1], w[2], w[3]}; }
            __syncthreads();
        }
    }
    {
        const int gw = blockIdx.x * 8 + wave, NGW = G * 8;
        bf16_t* ZMQ = (bf16_t*)(ws + WS_ZMQ); bf16_t* ZMKV = (bf16_t*)(ws + WS_ZMKV);
        bf16_t* CK = (bf16_t*)(ws + WS_CKVALL); bf16_t* KP = (bf16_t*)(ws + WS_KPEALL);
        const float* gq = a.in[12]; const float* gkv = a.in[14]; const float* gkp = a.in[19]; const float* RT = (const float*)(ws + WS_ROPE);
        float* CKO = a.out + O_CKV; float* KPO = a.out + O_KPE;
        for (int m = gw; m < MA; m += NGW) {
            {
                bf16_t* p = ZMQ + (size_t)m * 512 + 8 * lane; const u32x4 w = __builtin_nontemporal_load((const u32x4*)p);
                float x[8] = {bflo(w.x), bfhi(w.x), bflo(w.y), bfhi(w.y), bflo(w.z), bfhi(w.z), bflo(w.w), bfhi(w.w)};
                float ss = 0.f;
#pragma unroll
                for (int j = 0; j < 8; ++j) ss += x[j] * x[j];
                ss = wave_sum(ss); const float rstd = 1.0f / sqrtf(ss * (1.f / 512.f) + EPS);
                const f32x4 g0 = *(const f32x4*)(gq + 8 * lane), g1 = *(const f32x4*)(gq + 8 * lane + 4);
                u32x4 o; o.x = pk2(x[0] * rstd * g0.x, x[1] * rstd * g0.y); o.y = pk2(x[2] * rstd * g0.z, x[3] * rstd * g0.w);
                o.z = pk2(x[4] * rstd * g1.x, x[5] * rstd * g1.y); o.w = pk2(x[6] * rstd * g1.z, x[7] * rstd * g1.w);
                *(u32x4*)p = o;
            }
            const size_t kr = (size_t)kvrow(m);
            {
                const u32x4 w = __builtin_nontemporal_load((const u32x4*)(ZMKV + (size_t)m * 512 + 8 * lane));
                float x[8] = {bflo(w.x), bfhi(w.x), bflo(w.y), bfhi(w.y), bflo(w.z), bfhi(w.z), bflo(w.w), bfhi(w.w)};
                float ss = 0.f;
#pragma unroll
                for (int j = 0; j < 8; ++j) ss += x[j] * x[j];
                ss = wave_sum(ss); const float rstd = 1.0f / sqrtf(ss * (1.f / 512.f) + EPS);
                const f32x4 g0 = *(const f32x4*)(gkv + 8 * lane), g1 = *(const f32x4*)(gkv + 8 * lane + 4);
                const f32x4 y0 = {x[0] * rstd * g0.x, x[1] * rstd * g0.y, x[2] * rstd * g0.z, x[3] * rstd * g0.w};
                const f32x4 y1 = {x[4] * rstd * g1.x, x[5] * rstd * g1.y, x[6] * rstd * g1.z, x[7] * rstd * g1.w};
                *(f32x4*)(CKO + (size_t)m * 512 + 8 * lane) = y0; *(f32x4*)(CKO + (size_t)m * 512 + 8 * lane + 4) = y1;
                u32x4 o; o.x = pk2(y0.x, y0.y); o.y = pk2(y0.z, y0.w); o.z = pk2(y1.x, y1.y); o.w = pk2(y1.z, y1.w);
                *(u32x4*)(CK + kr * 512 + 8 * lane) = o;
            }
            {
                const bf16_t* zm = ZMISC + (size_t)m * 256; const int i = lane & 31;
                const float x1 = bf2f(zm[i]), x2 = bf2f(zm[32 + i]);
                float ss = lane < 32 ? x1 * x1 + x2 * x2 : 0.f; ss = wave_sum(ss); const float rstd = 1.0f / sqrtf(ss * (1.f / 64.f) + EPS);
                if (lane < 32) { const float y1 = x1 * rstd * gkp[i], y2 = x2 * rstd * gkp[32 + i];
                    const float c = RT[(tokpos(m) * 32 + i) * 2], s = RT[(tokpos(m) * 32 + i) * 2 + 1];
                    const float o1 = y1 * c - y2 * s, o2 = y2 * c + y1 * s;
                    KPO[(size_t)m * 64 + i] = o1; KPO[(size_t)m * 64 + 32 + i] = o2;
                    *(unsigned*)(KP + kr * 64 + 2 * i) = pk2(o1, o2); }
            }
        }
    }
}

struct EpiHead {
    static constexpr bool PERM = true, AFTER_DRAIN = false, HAS_MID = false;
    bf16_t* O0; int ld0; const float* gain0; int nsplit; bf16_t* O1; int ld1; const float* gain1; const float* RT; LAS float* xs; float oscale;
    __device__ __forceinline__ void operator()(const pg8::f32x4 (&acc)[2][2][4][2], const pg8::Unit& u, int wr, int wc, int fr, int fq) const {
#pragma unroll
        for (int ai = 0; ai < 2; ++ai)
#pragma unroll
            for (int m = 0; m < 4; ++m)
#pragma unroll
                for (int bj = 0; bj < 2; ++bj) { const pg8::f32x4 v0 = acc[ai][bj][m][0], v1 = acc[ai][bj][m][1];
                    float s = (v0[0] * v0[0] + v0[1] * v0[1]) + (v0[2] * v0[2] + v0[3] * v0[3]) + (v1[0] * v1[0] + v1[1] * v1[1]) + (v1[2] * v1[2] + v1[3] * v1[3]);
                    s += __shfl_xor(s, 16); s += __shfl_xor(s, 32);
                    if (fq == 0) xs[((ai * 128 + wr * 64 + m * 16 + fr) * 2 + bj) * 4 + wc] = s; __builtin_amdgcn_sched_barrier(0); }
        asm volatile("s_waitcnt lgkmcnt(0)" ::: "memory"); __builtin_amdgcn_s_barrier(); asm volatile("" ::: "memory");
        const bool rope = u.pn >= nsplit;
        int cl = wc * 32 + 8 * fq;
        asm volatile("" : "+v"(cl));
        if (!rope) {
            const pg8::f32x4 g0 = *(const pg8::f32x4*)(gain0 + cl), g1 = *(const pg8::f32x4*)(gain0 + cl + 4);
#pragma unroll
            for (int ai = 0; ai < 2; ++ai)
#pragma unroll
                for (int m = 0; m < 4; ++m) { const int rl = ai * 128 + wr * 64 + m * 16 + fr; bf16_t* rowp = O0 + (size_t)(u.pm * 256 + rl) * ld0 + u.pn * 256 + cl;
#pragma unroll
                    for (int bj = 0; bj < 2; ++bj) { const pg8::f32x4 p = *(const LAS pg8::f32x4*)(xs + (rl * 2 + bj) * 4);
                        const float rstd = oscale / sqrtf(((p[0] + p[1]) + (p[2] + p[3])) * (1.f / 128.f) + EPS);
                        const pg8::f32x4 v0 = acc[ai][bj][m][0] * rstd * g0, v1 = acc[ai][bj][m][1] * rstd * g1;
                        u32x4 w; w.x = pk2(v0[0], v0[1]); w.y = pk2(v0[2], v0[3]); w.z = pk2(v1[0], v1[1]); w.w = pk2(v1[2], v1[3]);
                        *(u32x4*)(rowp + bj * 128) = w; } __builtin_amdgcn_sched_barrier(0); }
        } else {
            const int p0 = cl & 63, i0 = p0 >> 1;
            float ga[8];
#pragma unroll
            for (int j = 0; j < 8; ++j) ga[j] = gain1[((p0 + j) & 1) * 32 + ((p0 + j) >> 1)];
#pragma unroll
            for (int ai = 0; ai < 2; ++ai)
#pragma unroll
                for (int m = 0; m < 4; ++m) { const int rl = ai * 128 + wr * 64 + m * 16 + fr, row = u.pm * 256 + rl;
                    bf16_t* rowp = O1 + (size_t)row * ld1 + (u.pn - nsplit) * 256 + cl;
                    const float* rt = RT + ((size_t)tokpos(row) * 32 + i0) * 2;
                    const pg8::f32x4 cs0 = *(const pg8::f32x4*)rt, cs1 = *(const pg8::f32x4*)(rt + 4);
#pragma unroll
                    for (int bj = 0; bj < 2; ++bj) { const pg8::f32x4 p = *(const LAS pg8::f32x4*)(xs + (rl * 2 + bj) * 4);
                        const float tot = wc < 2 ? p[0] + p[1] : p[2] + p[3];
                        const float rstd = oscale / sqrtf(tot * (1.f / 64.f) + EPS);
                        const pg8::f32x4 a0 = acc[ai][bj][m][0], a1 = acc[ai][bj][m][1];
                        const float y0 = a0[0] * rstd * ga[0], y1 = a0[1] * rstd * ga[1], y2 = a0[2] * rstd * ga[2], y3 = a0[3] * rstd * ga[3];
                        const float y4 = a1[0] * rstd * ga[4], y5 = a1[1] * rstd * ga[5], y6 = a1[2] * rstd * ga[6], y7 = a1[3] * rstd * ga[7];
                        u32x4 w;
                        w.x = pk2(y0 * cs0[0] - y1 * cs0[1], y1 * cs0[0] + y0 * cs0[1]);
                        w.y = pk2(y2 * cs0[2] - y3 * cs0[3], y3 * cs0[2] + y2 * cs0[3]);
                        w.z = pk2(y4 * cs1[0] - y5 * cs1[1], y5 * cs1[0] + y4 * cs1[1]);
                        w.w = pk2(y6 * cs1[2] - y7 * cs1[3], y7 * cs1[2] + y6 * cs1[3]);
                        *(u32x4*)(rowp + bj * 128) = w; } __builtin_amdgcn_sched_barrier(0); }
        }
    }
};
struct EpiVT {
    static constexpr bool PERM = false, AFTER_DRAIN = false, HAS_MID = false;
    bf16_t* O;
    __device__ __forceinline__ void operator()(const pg8::f32x4 (&acc)[2][2][4][2], const pg8::Unit& u, int wr, int wc, int fr, int fq) const {
        const int pos = (fq & 1) * 8 + (fq >> 1) * 4;
#pragma unroll
        for (int ai = 0; ai < 2; ++ai)
#pragma unroll
            for (int m = 0; m < 4; ++m) { bf16_t* rowp = O + (size_t)(u.pm * 256 + ai * 128 + wr * 64 + m * 16 + fr) * VTP + u.pn * 256 + wc * 32 + pos;
#pragma unroll
                for (int bj = 0; bj < 2; ++bj)
#pragma unroll
                    for (int n = 0; n < 2; ++n) { const pg8::f32x4 v = acc[ai][bj][m][n]; u32x2 w; w.x = pk2(v[0], v[1]); w.y = pk2(v[2], v[3]);
                        *(u32x2*)(rowp + bj * 128 + n * 16) = w; } }
    }
};
__device__ __forceinline__ float sigmoidf_(float x) { return 1.0f / (1.0f + __expf(-x)); }
struct EpiX1 {
    static constexpr bool PERM = true, AFTER_DRAIN = false, HAS_MID = false;
    const float* xp; const float* xs_; float* Y; bf16_t* X1B; float* SS;
    __device__ __forceinline__ void operator()(const pg8::f32x4 (&acc)[2][2][4][2], const pg8::Unit& u, int wr, int wc, int fr, int fq) const {
        const int row0 = u.pm * 256 + wr * 64 + fr, col0 = u.pn * 256 + wc * 32 + 8 * fq;
#pragma unroll
        for (int ai = 0; ai < 2; ++ai)
#pragma unroll
            for (int m = 0; m < 4; ++m) { const int row = row0 + ai * 128 + m * 16; const size_t ro = (size_t)row * DM + col0;
                const float* xr = row < MP ? xp + ro : xs_ + (ro - (size_t)MP * DM);
                float ss = 0.f;
#pragma unroll
                for (int bj = 0; bj < 2; ++bj) { const pg8::f32x4 x0 = __builtin_nontemporal_load((const pg8::f32x4*)(xr + bj * 128)), x1 = __builtin_nontemporal_load((const pg8::f32x4*)(xr + bj * 128 + 4));
                    const pg8::f32x4 o0 = x0 + acc[ai][bj][m][0], o1 = x1 + acc[ai][bj][m][1];
                    __builtin_nontemporal_store(o0, (pg8::f32x4*)(Y + ro + bj * 128)); __builtin_nontemporal_store(o1, (pg8::f32x4*)(Y + ro + bj * 128 + 4));
                    u32x4 w; w.x = pk2(o0[0], o0[1]); w.y = pk2(o0[2], o0[3]); w.z = pk2(o1[0], o1[1]); w.w = pk2(o1[2], o1[3]);
                    *(u32x4*)(X1B + ro + bj * 128) = w;
                    ss += (o0[0] * o0[0] + o0[1] * o0[1]) + (o0[2] * o0[2] + o0[3] * o0[3]) + (o1[0] * o1[0] + o1[1] * o1[1]) + (o1[2] * o1[2] + o1[3] * o1[3]); }
                ss += __shfl_xor(ss, 16); ss += __shfl_xor(ss, 32);
                if (fq == 0) unsafeAtomicAdd(SS + row, ss); }
    }
};
struct EpiY {
    static constexpr bool PERM = true, AFTER_DRAIN = false, HAS_MID = false;
    float* Y;
    __device__ __forceinline__ void operator()(const pg8::f32x4 (&acc)[2][2][4][2], const pg8::Unit& u, int wr, int wc, int fr, int fq) const {
        const int row0 = u.pm * 256 + wr * 64 + fr, col0 = u.pn * 256 + wc * 32 + 8 * fq;
#pragma unroll
        for (int ai = 0; ai < 2; ++ai)
#pragma unroll
            for (int m = 0; m < 4; ++m) { float* rp = Y + (size_t)(row0 + ai * 128 + m * 16) * DM + col0;
#pragma unroll
                for (int bj = 0; bj < 2; ++bj) { const pg8::f32x4 x0 = __builtin_nontemporal_load((const pg8::f32x4*)(rp + bj * 128)), x1 = __builtin_nontemporal_load((const pg8::f32x4*)(rp + bj * 128 + 4));
                    *(pg8::f32x4*)(rp + bj * 128) = x0 + acc[ai][bj][m][0]; *(pg8::f32x4*)(rp + bj * 128 + 4) = x1 + acc[ai][bj][m][1]; } }
    }
};

struct EpiPart {
    static constexpr bool PERM = true, AFTER_DRAIN = false, HAS_MID = false;
    float* P;
    __device__ __forceinline__ void operator()(const pg8::f32x4 (&acc)[2][2][4][2], const pg8::Unit& u, int wr, int wc, int fr, int fq) const {
        int row0 = wr * 64 + fr; const int col0 = u.pn * 256 + wc * 32 + 8 * fq;
        asm volatile("" : "+v"(row0));
        float* base = P + (size_t)(u.kofs >> 8) * 256 * DM;
#pragma unroll
        for (int ai = 0; ai < 2; ++ai)
#pragma unroll
            for (int m = 0; m < 4; ++m) { float* rp = base + (size_t)(row0 + ai * 128 + m * 16) * DM + col0;
#pragma unroll
                for (int bj = 0; bj < 2; ++bj) { *(pg8::f32x4*)(rp + bj * 128) = acc[ai][bj][m][0]; *(pg8::f32x4*)(rp + bj * 128 + 4) = acc[ai][bj][m][1]; } }
    }
};

struct EpiMerge {
    static constexpr bool PERM = true, AFTER_DRAIN = false, HAS_MID = true;
    const bf16_t* GA; const bf16_t* GB; bf16_t* MB;
    __device__ __forceinline__ void mid(pg8::f32x4 (&acc)[2][2][4][2], const pg8::Unit& u, int wr, int wc, int fr, int fq) const {
        int row0 = u.pm * 256 + wr * 64 + fr; const int col0 = u.pn * 256 + wc * 32 + 8 * fq;
        asm volatile("" : "+v"(row0));
#pragma unroll
        for (int ai = 0; ai < 2; ++ai)
#pragma unroll
            for (int m = 0; m < 4; ++m) { const size_t ro = (size_t)(row0 + ai * 128 + m * 16) * DM + col0;
#pragma unroll
                for (int bj = 0; bj < 2; ++bj) { const u32x4 ga = __builtin_nontemporal_load((const u32x4*)(GA + ro + bj * 128)), gb = *(const u32x4*)(GB + ro + bj * 128);
                    const float a[8] = {bflo(ga.x), bfhi(ga.x), bflo(ga.y), bfhi(ga.y), bflo(ga.z), bfhi(ga.z), bflo(ga.w), bfhi(ga.w)};
                    const float b[8] = {bflo(gb.x), bfhi(gb.x), bflo(gb.y), bfhi(gb.y), bflo(gb.z), bfhi(gb.z), bflo(gb.w), bfhi(gb.w)};
#pragma unroll
                    for (int j = 0; j < 8; ++j) { const float r = (1.0f + __expf(-b[j])) / (1.0f + __expf(-a[j])); acc[ai][bj][m][j >> 2][j & 3] *= r; } } }
    }
    __device__ __forceinline__ void operator()(const pg8::f32x4 (&acc)[2][2][4][2], const pg8::Unit& u, int wr, int wc, int fr, int fq) const {
        int row0 = u.pm * 256 + wr * 64 + fr; const int col0 = u.pn * 256 + wc * 32 + 8 * fq;
        asm volatile("" : "+v"(row0));
#pragma unroll
        for (int ai = 0; ai < 2; ++ai)
#pragma unroll
            for (int m = 0; m < 4; ++m) { const size_t ro = (size_t)(row0 + ai * 128 + m * 16) * DM + col0;
#pragma unroll
                for (int bj = 0; bj < 2; ++bj) { const u32x4 g = *(const u32x4*)(GB + ro + bj * 128);
                    const pg8::f32x4 a0 = acc[ai][bj][m][0], a1 = acc[ai][bj][m][1];
                    u32x4 w;
                    w.x = pk2(a0[0] * sigmoidf_(bflo(g.x)), a0[1] * sigmoidf_(bfhi(g.x)));
                    w.y = pk2(a0[2] * sigmoidf_(bflo(g.y)), a0[3] * sigmoidf_(bfhi(g.y)));
                    w.z = pk2(a1[0] * sigmoidf_(bflo(g.z)), a1[1] * sigmoidf_(bfhi(g.z)));
                    w.w = pk2(a1[2] * sigmoidf_(bflo(g.w)), a1[3] * sigmoidf_(bfhi(g.w)));
                    *(u32x4*)(MB + ro + bj * 128) = w; } }
    }
};

typedef float f32x2e __attribute__((ext_vector_type(2)));
__device__ __forceinline__ f32x2e gelu_pk2(f32x2e v) {
    const f32x2e av = __builtin_elementwise_abs(v), d = av * 0.2316418882f + 1.0f;
    f32x2e t; t.x = __builtin_amdgcn_rcpf(d.x); t.y = __builtin_amdgcn_rcpf(d.y);
    f32x2e q = t * 0.5307027145f + (-0.7265760135f); q = q * t + 0.7107068705f; q = q * t + (-0.142248368f); q = q * t + 0.127414796f; q = q * t;
    const f32x2e s = (v * v) * (-0.72134752044f);
    f32x2e e; e.x = __builtin_amdgcn_exp2f(s.x); e.y = __builtin_amdgcn_exp2f(s.y);
    const f32x2e m = v * (q * e), r = v - m;
    f32x2e o; o.x = v.x < 0.f ? m.x : r.x; o.y = v.y < 0.f ? m.y : r.y; return o;
}
__device__ __forceinline__ float dpp_shr1(float v, float old) { return __int_as_float(__builtin_amdgcn_update_dpp(__float_as_int(old), __float_as_int(v), 0x111, 0xf, 0xf, false)); }
__device__ __forceinline__ float dpp_shr2(float v, float old) { return __int_as_float(__builtin_amdgcn_update_dpp(__float_as_int(old), __float_as_int(v), 0x112, 0xf, 0xf, false)); }
struct EpiUpG {
    static constexpr bool PERM = true, AFTER_DRAIN = false, HAS_MID = false;
    bf16_t* Gb; const float* SS; float* out; const float* cw; const float* cb; const float* hist; float* side;
    __device__ __forceinline__ void operator()(const pg8::f32x4 (&acc)[2][2][4][2], const pg8::Unit& u, int wr, int wc, int fr, int fq) const {
        int cl = wc * 32 + 8 * fq; asm volatile("" : "+v"(cl));
        const int lane = fq * 16 + fr, col = u.pn * 128 + cl;
        const bool sample = u.pm == MP / 256;
        float* AH = side; float* AF0 = side + 33 * 8 * DFF; float* GT0 = side + 2 * 33 * 8 * DFF;
        float w0[8], w1[8], w2[8], wb[8];
#pragma unroll
        for (int j = 0; j < 8; j += 4) { const pg8::f32x4 t0 = *(const pg8::f32x4*)(cw + col + j), t1 = *(const pg8::f32x4*)(cw + DFF + col + j), t2 = *(const pg8::f32x4*)(cw + 2 * DFF + col + j), t3 = *(const pg8::f32x4*)(cb + col + j);
#pragma unroll
            for (int e = 0; e < 4; ++e) { w0[j + e] = t0[e]; w1[j + e] = t1[e]; w2[j + e] = t2[e]; wb[j + e] = t3[e]; } }
#pragma unroll
        for (int ai = 0; ai < 2; ++ai) {
            float prev[8];
#pragma unroll
            for (int e = 0; e < 8; ++e) prev[e] = 0.f;
#pragma unroll
            for (int m = 0; m < 4; ++m) {
                const int row_l = ai * 128 + wr * 64 + m * 16 + fr, row = u.pm * 256 + row_l, blk = ai * 2 + wr;
                const float rstd = 1.0f / sqrtf(SS[row] * (1.f / 2048.f) + EPS);
                float av[8], gv[8], b1[8], b2[8];
#pragma unroll
                for (int e = 0; e < 8; ++e) { av[e] = acc[ai][0][m][e >> 2][e & 3] * rstd; gv[e] = acc[ai][1][m][e >> 2][e & 3] * rstd; b1[e] = 0.f; b2[e] = 0.f; }
                if (sample) {
                    if (fr < 2) { const float* hp = hist + (size_t)(row_l >> 4) * 2 * DFF + col;
#pragma unroll
                        for (int e = 0; e < 8; ++e) { b1[e] = hp[DFF + e]; b2[e] = fr == 0 ? hp[e] : hp[DFF + e]; } }
                } else if (m > 0) {
#pragma unroll
                    for (int e = 0; e < 8; ++e) { b1[e] = __shfl(prev[e], (lane & 48) | 15); b2[e] = __shfl(prev[e], (lane & 48) | (14 + (fr & 1))); }
                }
                const bool defer = !sample && m == 0 && fr < 2;
                float y[8];
#pragma unroll
                for (int e = 0; e < 8; e += 2) {
                    const float a1x = dpp_shr1(av[e], b1[e]), a1y = dpp_shr1(av[e + 1], b1[e + 1]), a2x = dpp_shr2(av[e], b2[e]), a2y = dpp_shr2(av[e + 1], b2[e + 1]);
                    f32x2e cv; cv.x = wb[e] + w2[e] * av[e] + w1[e] * a1x + w0[e] * a2x;
                    cv.y = wb[e + 1] + w2[e + 1] * av[e + 1] + w1[e + 1] * a1y + w0[e + 1] * a2y;
                    const f32x2e ge = gelu_pk2(cv); y[e] = ge.x * gv[e]; y[e + 1] = ge.y * gv[e + 1]; }
                if (!defer) { u32x4 o; o.x = pk2(y[0], y[1]); o.y = pk2(y[2], y[3]); o.z = pk2(y[4], y[5]); o.w = pk2(y[6], y[7]);
                    *(u32x4*)(Gb + (size_t)row * DFF + col) = o; }
                else { float* pa_ = AF0 + ((size_t)(u.pm * 4 + blk) * 2 + fr) * DFF + col; float* pg_ = GT0 + ((size_t)(u.pm * 4 + blk) * 2 + fr) * DFF + col;
#pragma unroll
                    for (int e = 0; e < 8; ++e) { pa_[e] = av[e]; pg_[e] = gv[e]; } }
                if (m == 3 && fr >= 14) { float* ph = AH + ((size_t)(u.pm * 4 + blk) * 2 + (fr - 14)) * DFF + col;
#pragma unroll
                    for (int e = 0; e < 8; ++e) ph[e] = av[e]; }
                {
                    float* fc = nullptr;
                    if (row < MP) { const int t = row & (TP - 1); if (t >= TP - 2) fc = out + O_FCP + ((size_t)(row >> 12) * 2 + (t - (TP - 2))) * DFF + col; }
                    else { const int r = row - MP, t = r & 15; if (t >= 14) fc = out + O_FCS + ((size_t)(r >> 4) * 2 + (t - 14)) * DFF + col; }
                    if (fc) {
#pragma unroll
                        for (int e = 0; e < 8; ++e) fc[e] = av[e]; }
                }
#pragma unroll
                for (int e = 0; e < 8; ++e) prev[e] = av[e];
                __builtin_amdgcn_sched_barrier(0);
            }
        }
    }
};

constexpr int GS_Q = 0, GS_KT = 33792, GS_VT = 70656, GS_EB = 75264, GS_STAGE = 76288;
__device__ __forceinline__ bf16x8 pack8(const f32x16& v, int b) {
    u32x4 w; w.x = pk2(v[b], v[b + 1]); w.y = pk2(v[b + 2], v[b + 3]); w.z = pk2(v[b + 4], v[b + 5]); w.w = pk2(v[b + 6], v[b + 7]); return __builtin_bit_cast(bf16x8, w);
}
struct GlaStageRegs { u32x4 q[6], k[6]; u32x2 v[2]; u32x4 e; };
__device__ __forceinline__ void gla_stage_issue(const Args& a, GlaStageRegs& R, int hw, int lane, int rowc, int h, int vs, int ci, int nvalid) {
    asm volatile("" : "+v"(lane));
    unsigned char* ws = a.ws;
    const bf16_t* ZQ = (const bf16_t*)(ws + WS_ZQ); const bf16_t* ZKT = (const bf16_t*)(ws + WS_ZKT); const bf16_t* ZV = (const bf16_t*)(ws + WS_ZV); const float* EBL = (const float*)(ws + WS_EBL);
    const u32x4 z4 = {0u, 0u, 0u, 0u};
    R.e = z4;
#pragma unroll
    for (int i = 0; i < 6; ++i) { const int c = hw * 64 + lane + 384 * i; R.q[i] = z4; R.k[i] = z4;
        if (c < 2048) { const int row = c >> 5, cc = c & 31; if (row < nvalid) R.q[i] = *(const u32x4*)(ZQ + (size_t)(rowc + row) * 1024 + h * 256 + 8 * cc);
                        const int d = c >> 3, kc = c & 7; if (8 * kc < nvalid) R.k[i] = *(const u32x4*)(ZKT + (size_t)(h * 256 + d) * MA + rowc + 8 * kc); } }
#pragma unroll
    for (int i = 0; i < 2; ++i) { const int c = hw * 64 + lane + 384 * i; R.v[i] = (u32x2){0u, 0u};
        if (c < 512) { const int s = c >> 3, v4 = (c & 7) * 4; if (s < nvalid) R.v[i] = __builtin_nontemporal_load((const u32x2*)(ZV + (size_t)(rowc + s) * 2048 + h * 512 + vs * 32 + v4)); } }
    { const int c = hw * 64 + lane; if (c < 64) R.e = *(const u32x4*)(EBL + (size_t)ci * 1024 + h * 256 + 4 * c); }
}
__device__ __forceinline__ void gla_stage_commit(LAS unsigned char* st, const GlaStageRegs& R, int hw, int lane) {
    asm volatile("" : "+v"(lane));
#pragma unroll
    for (int i = 0; i < 6; ++i) { const int c = hw * 64 + lane + 384 * i;
        if (c < 2048) { *(LAS u32x4*)(st + GS_Q + (c >> 5) * 528 + (c & 31) * 16) = R.q[i]; *(LAS u32x4*)(st + GS_KT + (c >> 3) * 144 + (c & 7) * 16) = R.k[i]; } }
#pragma unroll
    for (int i = 0; i < 2; ++i) { const int c = hw * 64 + lane + 384 * i;
        if (c < 512) { const int s = c >> 3, v4 = (c & 7) * 4; LAS bf16_t* vt = (LAS bf16_t*)(st + GS_VT);
            vt[(v4 + 0) * 72 + s] = (bf16_t)(R.v[i].x & 0xffffu); vt[(v4 + 1) * 72 + s] = (bf16_t)(R.v[i].x >> 16); vt[(v4 + 2) * 72 + s] = (bf16_t)(R.v[i].y & 0xffffu); vt[(v4 + 3) * 72 + s] = (bf16_t)(R.v[i].y >> 16); } }
    { const int c = hw * 64 + lane; if (c < 64) *(LAS u32x4*)(st + GS_EB + c * 16) = R.e; }
}
__device__ __forceinline__ void gla_item(const Args& a, LAS unsigned char* lds, int it) {
    int tid_ = threadIdx.x; asm volatile("" : "+v"(tid_)); const int tid = tid_, lane = tid & 63, wave = __builtin_amdgcn_readfirstlane(tid >> 6), l32 = lane & 31, hi = lane >> 5;
    unsigned char* ws = a.ws;
    bf16_t* ZV = (bf16_t*)(ws + WS_ZV); const bf16_t* AF = (const bf16_t*)(ws + WS_AF);
    {
        int seq, h, vs, nchunk, row0, ci0, nvalid; const float* S0 = nullptr;
        if (it < 128) { seq = it >> 6; h = (it >> 4) & 3; vs = it & 15; nchunk = 64; row0 = seq * TP; ci0 = seq * 64; nvalid = 64; }
        else { const int j = it - 128, st = j >> 6; h = (j >> 4) & 3; vs = j & 15; seq = 2 + st; nchunk = 1; row0 = MP + st * 16; ci0 = 128 + st; nvalid = 16; S0 = a.in[2] + (size_t)((st * 4 + h) * 256) * 512; }
        float* SO = a.out + O_ST + (size_t)((seq * 4 + h) * 256) * 512;
        f32x16 S[4]; GlaStageRegs R;
        const int dw = wave * 4;
        if (wave < 2) {
#pragma unroll
            for (int db = 0; db < 4; ++db)
#pragma unroll
                for (int r = 0; r < 16; ++r) S[db][r] = S0 ? __builtin_nontemporal_load(S0 + (size_t)(32 * (dw + db) + crow(r, hi)) * 512 + vs * 32 + l32) : 0.f;
        } else { gla_stage_issue(a, R, wave - 2, lane, row0, h, vs, ci0, nvalid); gla_stage_commit(lds, R, wave - 2, lane);
                 if (nchunk > 1) gla_stage_issue(a, R, wave - 2, lane, row0 + 64, h, vs, ci0 + 1, nvalid); }
        if (threadIdx.x == 64) *(volatile LAS unsigned*)(lds + 2 * GS_STAGE + 8) = 0u;
        __syncthreads();
        LAS float* XO = (LAS float*)(lds + 2 * GS_STAGE + 16);
        volatile LAS unsigned* xflag = (volatile LAS unsigned*)(lds + 2 * GS_STAGE + 8);
        for (int c = 0; c < nchunk; ++c) {
            LAS unsigned char* st = lds + (c & 1) * GS_STAGE;
            f32x16 o0 = {}, o1 = {};
            if (wave >= 2) { if (c + 1 < nchunk) { gla_stage_commit(lds + ((c + 1) & 1) * GS_STAGE, R, wave - 2, lane);
                                                   if (c + 2 < nchunk) gla_stage_issue(a, R, wave - 2, lane, row0 + 64 * (c + 2), h, vs, ci0 + c + 2, nvalid); } }
            else {
                int l32 = lane & 31, hi = lane >> 5; asm volatile("" : "+v"(l32), "+v"(hi));
                const LAS bf16_t* Qs = (const LAS bf16_t*)(st + GS_Q);
#pragma unroll
                for (int db = 0; db < 4; ++db)
#pragma unroll
                    for (int j = 0; j < 2; ++j) { const bf16x8 sf = pack8(S[db], 8 * j);
                        const bf16x8 q0 = *(const LAS bf16x8*)(Qs + l32 * 264 + 32 * (dw + db) + 16 * j + 8 * hi), q1 = *(const LAS bf16x8*)(Qs + (32 + l32) * 264 + 32 * (dw + db) + 16 * j + 8 * hi);
                        o0 = __builtin_amdgcn_mfma_f32_32x32x16_bf16(q0, sf, o0, 0, 0, 0); o1 = __builtin_amdgcn_mfma_f32_32x32x16_bf16(q1, sf, o1, 0, 0, 0);
                        __builtin_amdgcn_sched_barrier(0); }
                if (wave == 1) {
#pragma unroll
                    for (int r = 0; r < 16; ++r) { XO[r * 64 + lane] = o0[r]; XO[(16 + r) * 64 + lane] = o1[r]; }
                    asm volatile("s_waitcnt lgkmcnt(0)" ::: "memory");
                    if (lane == 0) xflag[0] = (unsigned)(c + 1);
                } else {
                    while (xflag[0] != (unsigned)(c + 1)) __builtin_amdgcn_s_sleep(1);
                    asm volatile("" ::: "memory");
                }
            }
            if (wave < 2) {
                int l32 = lane & 31, hi = lane >> 5; asm volatile("" : "+v"(l32), "+v"(hi));
                const LAS bf16_t* KT = (const LAS bf16_t*)(st + GS_KT); const LAS bf16_t* VT = (const LAS bf16_t*)(st + GS_VT);
                const LAS float* EB = (const LAS float*)(st + GS_EB);
                if (wave == 0) {
                    const int rowc = row0 + 64 * c;
#pragma unroll
                    for (int r = 0; r < 16; ++r) { o0[r] += XO[r * 64 + lane]; o1[r] += XO[(16 + r) * 64 + lane]; }
                    const bf16_t* afp = AF + ((size_t)((ci0 + c) * 4 + h) * 3 * 64 + lane) * 16;
                    bf16x8 af[3][2];
#pragma unroll
                    for (int tl = 0; tl < 3; ++tl) { af[tl][0] = *(const bf16x8*)(afp + (size_t)tl * 1024); af[tl][1] = *(const bf16x8*)(afp + (size_t)tl * 1024 + 8); }
#pragma unroll
                    for (int tl = 0; tl < 3; ++tl) { const int sb = tl == 2 ? 1 : 0;
#pragma unroll
                        for (int j = 0; j < 2; ++j) { const LAS bf16_t* vp = VT + l32 * 72 + 32 * sb + 16 * j + 4 * hi;
                            const u32x2 lo = *(const LAS u32x2*)vp, hi2 = *(const LAS u32x2*)(vp + 8);
                            const bf16x8 vf = __builtin_bit_cast(bf16x8, (u32x4){lo.x, lo.y, hi2.x, hi2.y});
                            if (tl == 0) o0 = __builtin_amdgcn_mfma_f32_32x32x16_bf16(af[tl][j], vf, o0, 0, 0, 0);
                            else o1 = __builtin_amdgcn_mfma_f32_32x32x16_bf16(af[tl][j], vf, o1, 0, 0, 0); } }
#pragma unroll
                    for (int r = 0; r < 16; ++r) { const int t = crow(r, hi);
                        if (t < nvalid) ZV[(size_t)(rowc + t) * 2048 + h * 512 + vs * 32 + l32] = (bf16_t)(pk2(o0[r], 0.f) & 0xffffu);
                        if (32 + t < nvalid) ZV[(size_t)(rowc + 32 + t) * 2048 + h * 512 + vs * 32 + l32] = (bf16_t)(pk2(o1[r], 0.f) & 0xffffu); }
                    __builtin_amdgcn_sched_barrier(0);
                }
#pragma unroll
                for (int db = 0; db < 4; ++db) { f32x16 acc = S[db];
#pragma unroll
                    for (int ks = 0; ks < 4; ++ks) { const bf16x8 kf = *(const LAS bf16x8*)(KT + (32 * (dw + db) + l32) * 72 + 16 * ks + 8 * hi), vf = *(const LAS bf16x8*)(VT + l32 * 72 + 16 * ks + 8 * hi);
                        acc = __builtin_amdgcn_mfma_f32_32x32x16_bf16(kf, vf, acc, 0, 0, 0); }
#pragma unroll
                    for (int q4 = 0; q4 < 4; ++q4) { const f32x4 e = *(const LAS f32x4*)(EB + 32 * (dw + db) + 8 * q4 + 4 * hi);
                        acc[4 * q4] *= e[0]; acc[4 * q4 + 1] *= e[1]; acc[4 * q4 + 2] *= e[2]; acc[4 * q4 + 3] *= e[3]; }
                    S[db] = acc; __builtin_amdgcn_sched_barrier(0); }
            }
            __syncthreads();
        }
        if (wave < 2) {
#pragma unroll
            for (int db = 0; db < 4; ++db)
#pragma unroll
                for (int r = 0; r < 16; ++r) SO[(size_t)(32 * (dw + db) + crow(r, hi)) * 512 + vs * 32 + l32] = S[db][r];
        }
        __syncthreads();
    }
}
__device__ __forceinline__ void gla_phase(const Args& a, LAS unsigned char* lds, int chain, int nscan) {
    unsigned* ctr = (unsigned*)(a.ws + WS_CTR); volatile LAS unsigned* bc = (volatile LAS unsigned*)(lds + 2 * GS_STAGE);
    for (;;) {
        int it;
        if (chain < 128) { it = chain; chain += nscan; }
        else {
            if (threadIdx.x == 0) bc[0] = atomicAdd(ctr, 1u);
            __syncthreads();
            const unsigned j = bc[0];
            __syncthreads();
            if (j >= 1024u) break;
            it = 128 + (int)j;
        }
        gla_item(a, lds, it);
    }
}
__device__ __forceinline__ void gla_norm(const Args& a, int G) {
    int tid_ = threadIdx.x; asm volatile("" : "+v"(tid_)); const int tid = tid_, lane = tid & 63, wave = __builtin_amdgcn_readfirstlane(tid >> 6), gw = blockIdx.x * 8 + wave, NGW = G * 8;
    const bf16_t* ZV = (const bf16_t*)(a.ws + WS_ZV); const bf16_t* ZR = (const bf16_t*)(a.ws + WS_ZR); bf16_t* OG = (bf16_t*)(a.out + O_Y); const float* go = a.in[10];
    const f32x4 g0 = *(const f32x4*)(go + 8 * lane), g1 = *(const f32x4*)(go + 8 * lane + 4);
    const float gg[8] = {g0.x, g0.y, g0.z, g0.w, g1.x, g1.y, g1.z, g1.w};
    for (int it0 = gw; it0 < MA * 4; it0 += 4 * NGW) {
        u32x4 w[4], rr[4]; float ss[4];
#pragma unroll
        for (int u = 0; u < 4; ++u) { const int it = it0 + u * NGW; if (it < MA * 4) { const size_t o = (size_t)(it >> 2) * 2048 + (it & 3) * 512 + 8 * lane; w[u] = __builtin_nontemporal_load((const u32x4*)(ZV + o)); rr[u] = __builtin_nontemporal_load((const u32x4*)(ZR + o)); }
            else { w[u] = (u32x4){0u, 0u, 0u, 0u}; rr[u] = w[u]; } }
#pragma unroll
        for (int u = 0; u < 4; ++u) { float x[8]; unpack8(w[u], x); float s_ = 0.f;
#pragma unroll
            for (int j = 0; j < 8; ++j) s_ += x[j] * x[j];
            ss[u] = s_; }
#pragma unroll
        for (int o_ = 1; o_ < 64; o_ <<= 1) {
#pragma unroll
            for (int u = 0; u < 4; ++u) ss[u] += __shfl_xor(ss[u], o_); }
#pragma unroll
        for (int u = 0; u < 4; ++u) { const int it = it0 + u * NGW; if (it < MA * 4) { const int m = it >> 2, h = it & 3;
            float x[8], r[8]; unpack8(w[u], x); unpack8(rr[u], r);
            const float rstd = 1.0f / sqrtf(ss[u] * (1.f / 512.f) + EPS);
            float y[8];
#pragma unroll
            for (int j = 0; j < 8; ++j) y[j] = x[j] * rstd * gg[j] * (r[j] / (1.0f + __expf(-r[j])));
            u32x4 ow; ow.x = pk2(y[0], y[1]); ow.y = pk2(y[2], y[3]); ow.z = pk2(y[4], y[5]); ow.w = pk2(y[6], y[7]);
            *(u32x4*)(OG + (size_t)m * 4096 + h * 512 + 8 * lane) = ow; } }
    }
}

constexpr float ATT_C = 0.07216878364870322f * 1.4426950408889634f;
template <class KF, class VF>
__device__ __forceinline__ void attn_tile(const bf16x8 (&qf)[12], float& l, f32x16 (&o)[4], const KF& kf, const VF& vf, int nvalid, int hi) {
    f32x16 p0 = {}, p1 = {};
    bf16x8 fa[4], fb[4];
#define AT_LDK(dst, g) do { dst[0] = kf(0, 2 * (g)); dst[1] = kf(1, 2 * (g)); dst[2] = kf(0, 2 * (g) + 1); dst[3] = kf(1, 2 * (g) + 1); } while (0)
#define AT_LDV(dst, vb) do { dst[0] = vf(vb, 0); dst[1] = vf(vb, 1); dst[2] = vf(vb, 2); dst[3] = vf(vb, 3); } while (0)
#define AT_QK(src, g) do { p0 = __builtin_amdgcn_mfma_f32_32x32x16_bf16(src[0], qf[2 * (g)], p0, 0, 0, 0); p1 = __builtin_amdgcn_mfma_f32_32x32x16_bf16(src[1], qf[2 * (g)], p1, 0, 0, 0); \
        p0 = __builtin_amdgcn_mfma_f32_32x32x16_bf16(src[2], qf[2 * (g) + 1], p0, 0, 0, 0); p1 = __builtin_amdgcn_mfma_f32_32x32x16_bf16(src[3], qf[2 * (g) + 1], p1, 0, 0, 0); } while (0)
#define AT_SB __builtin_amdgcn_sched_barrier(0)
    AT_LDK(fa, 0); AT_SB;
    AT_LDK(fb, 1); AT_SB; AT_QK(fa, 0); AT_SB;
    AT_LDK(fa, 2); AT_SB; AT_QK(fb, 1); AT_SB;
    AT_LDK(fb, 3); AT_SB; AT_QK(fa, 2); AT_SB;
    AT_LDK(fa, 4); AT_SB; AT_QK(fb, 3); AT_SB;
    AT_LDK(fb, 5); AT_SB; AT_QK(fa, 4); AT_SB;
    AT_LDV(fa, 0); AT_SB; AT_QK(fb, 5); AT_SB;
    if (nvalid < 64) {
#pragma unroll
        for (int r = 0; r < 16; ++r) { if (crow(r, hi) >= nvalid) p0[r] = -INFINITY; if (32 + crow(r, hi) >= nvalid) p1[r] = -INFINITY; }
    }
    float ls = 0.f;
#pragma unroll
    for (int r = 0; r < 16; ++r) { p0[r] = __builtin_amdgcn_exp2f(p0[r]); p1[r] = __builtin_amdgcn_exp2f(p1[r]); ls += p0[r] + p1[r]; }
    l += ls;
    const bf16x8 pa[4] = {pack8(p0, 0), pack8(p0, 8), pack8(p1, 0), pack8(p1, 8)};
#define AT_PV(src, vb) do { _Pragma("unroll") for (int c = 0; c < 4; ++c) o[vb] = __builtin_amdgcn_mfma_f32_32x32x16_bf16(src[c], pa[c], o[vb], 0, 0, 0); } while (0)
    AT_SB;
    AT_LDV(fb, 1); AT_SB; AT_PV(fa, 0); AT_SB;
    AT_LDV(fa, 2); AT_SB; AT_PV(fb, 1); AT_SB;
    AT_LDV(fb, 3); AT_SB; AT_PV(fa, 2); AT_SB;
    AT_PV(fb, 3); AT_SB;
#undef AT_LDK
#undef AT_LDV
#undef AT_QK
#undef AT_PV
#undef AT_SB
}
template <class KF, class VF>
__device__ __forceinline__ void attn_tile_s(const LAS unsigned char* qs, int lane, float& l, f32x16 (&o)[4], const KF& kf, const VF& vf, int nvalid, int hi) {
    f32x16 p0 = {}, p1 = {};
    bf16x8 f[16];
#define AT_SB __builtin_amdgcn_sched_barrier(0)
#pragma unroll
    for (int ks = 0; ks < 8; ++ks) { f[2 * ks] = kf(0, ks); f[2 * ks + 1] = kf(1, ks); }
    AT_SB;
#pragma unroll
    for (int ks = 0; ks < 8; ++ks) { const bf16x8 q = *(const LAS bf16x8*)(qs + ks * 1024 + lane * 16);
        p0 = __builtin_amdgcn_mfma_f32_32x32x16_bf16(f[2 * ks], q, p0, 0, 0, 0); p1 = __builtin_amdgcn_mfma_f32_32x32x16_bf16(f[2 * ks + 1], q, p1, 0, 0, 0); }
    AT_SB;
#pragma unroll
    for (int ks = 0; ks < 4; ++ks) { f[2 * ks] = kf(0, 8 + ks); f[2 * ks + 1] = kf(1, 8 + ks); }
#pragma unroll
    for (int i_ = 0; i_ < 8; ++i_) f[8 + i_] = vf(i_ >> 2, i_ & 3);
    AT_SB;
#pragma unroll
    for (int ks = 0; ks < 4; ++ks) { const bf16x8 q = *(const LAS bf16x8*)(qs + (8 + ks) * 1024 + lane * 16);
        p0 = __builtin_amdgcn_mfma_f32_32x32x16_bf16(f[2 * ks], q, p0, 0, 0, 0); p1 = __builtin_amdgcn_mfma_f32_32x32x16_bf16(f[2 * ks + 1], q, p1, 0, 0, 0); }
    AT_SB;
    bf16x8 g[8];
#pragma unroll
    for (int i_ = 0; i_ < 8; ++i_) g[i_] = vf(2 + (i_ >> 2), i_ & 3);
    AT_SB;
    if (nvalid < 64) {
#pragma unroll
        for (int r = 0; r < 16; ++r) { if (crow(r, hi) >= nvalid) p0[r] = -INFINITY; if (32 + crow(r, hi) >= nvalid) p1[r] = -INFINITY; }
    }
    float ls = 0.f;
#pragma unroll
    for (int r = 0; r < 16; ++r) { p0[r] = __builtin_amdgcn_exp2f(p0[r]); p1[r] = __builtin_amdgcn_exp2f(p1[r]); ls += p0[r] + p1[r]; }
    l += ls;
    const bf16x8 pa[4] = {pack8(p0, 0), pack8(p0, 8), pack8(p1, 0), pack8(p1, 8)};
    AT_SB;
#pragma unroll
    for (int i_ = 0; i_ < 8; ++i_) o[i_ >> 2] = __builtin_amdgcn_mfma_f32_32x32x16_bf16(f[8 + i_], pa[i_ & 3], o[i_ >> 2], 0, 0, 0);
    AT_SB;
#pragma unroll
    for (int i_ = 0; i_ < 8; ++i_) o[2 + (i_ >> 2)] = __builtin_amdgcn_mfma_f32_32x32x16_bf16(g[i_], pa[i_ & 3], o[2 + (i_ >> 2)], 0, 0, 0);
    AT_SB;
#undef AT_SB
}
struct KFLds { const LAS unsigned char* kn; const LAS unsigned char* kp; int l32, hi;
    __device__ __forceinline__ bf16x8 operator()(int p, int ks) const { const int row = 32 * p + l32;
        if (ks < 8) return *(const LAS bf16x8*)(kn + row * 256 + (((2 * ks + hi) ^ (row & 15)) << 4));
        return *(const LAS bf16x8*)(kp + row * 128 + (((2 * (ks - 8) + hi) ^ ((row >> 1) & 7)) << 4)); } };
struct VFLds { const LAS unsigned char* vt; int l32, hi;
    __device__ __forceinline__ bf16x8 operator()(int vb, int c) const { const int row = 32 * vb + l32; return *(const LAS bf16x8*)(vt + row * 128 + (((2 * c + hi) ^ ((row >> 1) & 7)) << 4)); } };
struct KFGlb { const bf16_t* kn; const bf16_t* kp; int hi;
    __device__ __forceinline__ bf16x8 operator()(int p, int ks) const {
        if (ks < 8) return *(const bf16x8*)(kn + (size_t)p * 32 * 2048 + 16 * ks + 8 * hi);
        return *(const bf16x8*)(kp + (size_t)p * 32 * 64 + 16 * (ks - 8) + 8 * hi); } };
struct VFGlb { const bf16_t* vt; int hi;
    __device__ __forceinline__ bf16x8 operator()(int vb, int c) const { return *(const bf16x8*)(vt + (size_t)vb * 32 * VTP + 16 * c + 8 * hi); } };

constexpr int AT_KN = 0, AT_KP = 16384, AT_VT = 24576, AT_BUF = 40960;
__device__ __forceinline__ void attention_phase(const Args& a, LAS unsigned char* lds, int G) {
    int tid_ = threadIdx.x; asm volatile("" : "+v"(tid_)); const int tid = tid_, lane = tid & 63, wave = __builtin_amdgcn_readfirstlane(tid >> 6), l32 = lane & 31, hi = lane >> 5;
    unsigned char* ws = a.ws;
    const bf16_t* QN = (const bf16_t*)(ws + WS_E); const bf16_t* QP = (const bf16_t*)(ws + WS_D);
    const bf16_t* KN = (const bf16_t*)(ws + WS_KN); const bf16_t* KPE = (const bf16_t*)(ws + WS_KPEALL); const bf16_t* VT = (const bf16_t*)(ws + WS_VT);
    bf16_t* ATT = (bf16_t*)(a.out + O_Y) + 2048;
    const int vcu = (G % 8 == 0) ? (blockIdx.x % 8) * (G / 8) + blockIdx.x / 8 : blockIdx.x;
    for (int pr = vcu; pr < 256; pr += G) {
        const int bh = pr >> 3, b = bh >> 4, h = bh & 15;
        for (int half = 0; half < 2; ++half) {
            const int qb = half == 0 ? (pr & 7) : 15 - (pr & 7), q0 = qb * 256, NT = (q0 >> 6) + 4, wch = (q0 >> 6) + (wave >> 1);
            const size_t qrow = (size_t)b * TP + q0 + wave * 32 + l32;
            bf16x8 qf[12];
#pragma unroll
            for (int ks = 0; ks < 8; ++ks) qf[ks] = __builtin_nontemporal_load((const bf16x8*)(QN + qrow * 2048 + h * 128 + 16 * ks + 8 * hi));
#pragma unroll
            for (int ks = 0; ks < 4; ++ks) qf[8 + ks] = __builtin_nontemporal_load((const bf16x8*)(QP + qrow * 1024 + h * 64 + 16 * ks + 8 * hi));
            float l = 0.f; f32x16 o[4] = {};
            const size_t kv0 = (size_t)b * TP;
#define AT_DMA(j, buf) do { const size_t kr = kv0 + 64 * (size_t)(j); LAS unsigned char* bb = lds + (buf) * AT_BUF; \
                _Pragma("unroll") for (int i = 0; i < 2; ++i) { const int rg = 2 * wave + i; \
                    { const int row = 4 * rg + (lq >> 4), ch = (lq & 15) ^ (row & 15); \
                      __builtin_amdgcn_global_load_lds((const unsigned*)(KN + (kr + row) * 2048 + h * 128 + 8 * ch), (LAS unsigned*)(bb + AT_KN + rg * 1024), 16, 0, 0); } \
                    { const int row = 8 * rg + (lq >> 3), ch = (lq & 7) ^ ((row >> 1) & 7); \
                      __builtin_amdgcn_global_load_lds((const unsigned*)(VT + (size_t)(h * 128 + row) * VTP + kr + 8 * ch), (LAS unsigned*)(bb + AT_VT + rg * 1024), 16, 0, 0); } } \
                { const int row = 8 * wave + (lq >> 3), ch = (lq & 7) ^ ((row >> 1) & 7); \
                  __builtin_amdgcn_global_load_lds((const unsigned*)(KPE + (kr + row) * 64 + 8 * ch), (LAS unsigned*)(bb + AT_KP + wave * 1024), 16, 0, 0); } } while (0)
            int lq = lane; asm volatile("" : "+v"(lq));
            AT_DMA(0, 0); AT_DMA(1, 1);
            int slot = 0;
            for (int j = 0; j < NT; ++j) {
                if (j + 1 < NT) asm volatile("s_waitcnt vmcnt(5)" ::: "memory"); else asm volatile("s_waitcnt vmcnt(0)" ::: "memory");
                __builtin_amdgcn_s_barrier(); asm volatile("" ::: "memory");
                lq = lane; asm volatile("" : "+v"(lq));
                { const int s2 = slot >= 1 ? slot - 1 : 2;
                  if (j + 2 < NT) AT_DMA(j + 2, s2); }
                if (j <= wch) {
                    const LAS unsigned char* bb = lds + slot * AT_BUF;
                    const KFLds kf{bb + AT_KN, bb + AT_KP, l32, hi}; const VFLds vf{bb + AT_VT, l32, hi};
                    attn_tile(qf, l, o, kf, vf, 64, hi);
                }
                slot = slot == 2 ? 0 : slot + 1;
                asm volatile("s_waitcnt lgkmcnt(0)" ::: "memory");
            }
            __syncthreads();
            l += __shfl_xor(l, 32); const float inv = 1.0f / l;
            bf16_t* op = ATT + qrow * 4096 + h * 128;
#pragma unroll
            for (int vb = 0; vb < 4; ++vb)
#pragma unroll
                for (int q4 = 0; q4 < 4; ++q4) { u32x2 w; w.x = pk2(o[vb][4 * q4] * inv, o[vb][4 * q4 + 1] * inv); w.y = pk2(o[vb][4 * q4 + 2] * inv, o[vb][4 * q4 + 3] * inv);
                    *(u32x2*)(op + 32 * vb + 8 * q4 + 4 * hi) = w; }
        }
    }
#undef AT_DMA
    for (int it = blockIdx.x; it < 256; it += G) {
        const int db = it >> 4, h = it & 15; const size_t kv0 = (size_t)MP + db * KSS;
        const size_t qrow = (size_t)MP + db * 16 + (l32 & 15);
        const LAS unsigned char* qs = lds + 66560;
        if (wave == 0) { const bf16x8 z8 = {0, 0, 0, 0, 0, 0, 0, 0};
#pragma unroll
            for (int ks = 0; ks < 8; ++ks) *(LAS bf16x8*)(lds + 66560 + ks * 1024 + lane * 16) = l32 < 16 ? *(const bf16x8*)(QN + qrow * 2048 + h * 128 + 16 * ks + 8 * hi) : z8;
#pragma unroll
            for (int ks = 0; ks < 4; ++ks) *(LAS bf16x8*)(lds + 66560 + (8 + ks) * 1024 + lane * 16) = l32 < 16 ? *(const bf16x8*)(QP + qrow * 1024 + h * 64 + 16 * ks + 8 * hi) : z8; }
        __syncthreads();
        float l = 0.f; f32x16 o[4] = {};
        for (int j = wave; j < 17; j += 8) {
            const size_t kr = kv0 + 64 * (size_t)j;
            const KFGlb kf{KN + (kr + l32) * 2048 + h * 128, KPE + (kr + l32) * 64, hi}; const VFGlb vf{VT + (size_t)(h * 128 + l32) * VTP + kr, hi};
            attn_tile_s(qs, lane, l, o, kf, vf, KSS - 64 * j, hi);
        }
        l += __shfl_xor(l, 32);
        LAS float* Mw = (LAS float*)lds; LAS float* Lw = Mw + 128; LAS float* Ow = Mw + 256;
        if (l32 < 16) { if (hi == 0) { Lw[wave * 16 + l32] = l; }
#pragma unroll
            for (int vb = 0; vb < 4; ++vb)
#pragma unroll
                for (int q4 = 0; q4 < 4; ++q4) *(LAS f32x4*)(Ow + (wave * 16 + l32) * 128 + 32 * vb + 8 * q4 + 4 * hi) = (f32x4){o[vb][4 * q4], o[vb][4 * q4 + 1], o[vb][4 * q4 + 2], o[vb][4 * q4 + 3]}; }
        __syncthreads();
        { const int q = tid >> 5, v4 = (tid & 31) * 4;
          float L = 0.f; f32x4 O = {0.f, 0.f, 0.f, 0.f};
#pragma unroll
          for (int w = 0; w < 8; ++w) { L += Lw[w * 16 + q]; O += *(const LAS f32x4*)(Ow + (w * 16 + q) * 128 + v4); }
          const float inv = 1.0f / L; u32x2 wv; wv.x = pk2(O[0] * inv, O[1] * inv); wv.y = pk2(O[2] * inv, O[3] * inv);
          *(u32x2*)(ATT + ((size_t)MP + db * 16 + q) * 4096 + h * 128 + v4) = wv; }
        __syncthreads();
    }
}
typedef float f32x2 __attribute__((ext_vector_type(2)));
__device__ __forceinline__ f32x2 gelu_pk(f32x2 v) {
    const f32x2 av = __builtin_elementwise_abs(v), d = av * 0.2316418882f + 1.0f;
    f32x2 t; t.x = __builtin_amdgcn_rcpf(d.x); t.y = __builtin_amdgcn_rcpf(d.y);
    f32x2 q = t * 0.5307027145f + (-0.7265760135f); q = q * t + 0.7107068705f; q = q * t + (-0.142248368f); q = q * t + 0.127414796f; q = q * t;
    const f32x2 s = (v * v) * (-0.72134752044f);
    f32x2 e; e.x = __builtin_amdgcn_exp2f(s.x); e.y = __builtin_amdgcn_exp2f(s.y);
    const f32x2 m = v * (q * e), r = v - m;
    f32x2 o; o.x = v.x < 0.f ? m.x : r.x; o.y = v.y < 0.f ? m.y : r.y; return o;
}
#define RLX_AGENT __ATOMIC_RELAXED, __HIP_MEMORY_SCOPE_AGENT
#define XB_TMO      128
#define XB_XCNT(j)  (256  + 64 * (j))
#define XB_XSUB(j)  (1280 + 64 * (j))
#define XB_XGEN(j)  (2304 + 64 * (j))
#define XB_TOP      3328
#define XB_TOPGEN   3392
#define XCD_BAR_WORDS 3456
#define XB_SPIN_CAP (1u << 18)

__device__ __forceinline__ unsigned xb_ld(unsigned* p)              { return __hip_atomic_load(p, __ATOMIC_RELAXED, __HIP_MEMORY_SCOPE_AGENT); }
__device__ __forceinline__ unsigned xb_add(unsigned* p, unsigned v) { return __hip_atomic_fetch_add(p, v, __ATOMIC_RELAXED, __HIP_MEMORY_SCOPE_AGENT); }
__device__ __forceinline__ unsigned xb_xcc_id() { return (unsigned)__builtin_amdgcn_s_getreg((3 << 11) | 20) & 0xFu; }
#define XB_SPIN(cond, bar) do { unsigned _sp = 0; while (cond) { __builtin_amdgcn_s_sleep(1); \
    if ((++_sp & 255u) == 0u) { if (xb_ld(&(bar)[XB_TMO])) break; if (_sp > XB_SPIN_CAP) { atomicAdd(&(bar)[XB_TMO], 1u); break; } } } } while (0)

struct XcdBarrier {
    unsigned* bar; unsigned x;
    volatile LAS unsigned* st;
};

__device__ __forceinline__ XcdBarrier xcd_barrier_post(unsigned* bar, volatile LAS unsigned* st) {
    XcdBarrier b; b.bar = bar; b.x = xb_xcc_id(); b.st = st;
    if (threadIdx.x == 0) (void)xb_add(&bar[XB_XCNT(b.x)], 1u);
    return b;
}
__device__ __forceinline__ void xcd_barrier_complete(unsigned* bar, unsigned x, unsigned& nloc, unsigned& nx) {
    const unsigned G = gridDim.x * gridDim.y * gridDim.z;
    unsigned sum, cnt, mine, sp = 0u;
    for (;;) {
        sum = 0u; cnt = 0u; mine = 0u;
#pragma unroll
        for (unsigned j = 0; j < 16; ++j) { const unsigned c = xb_ld(&bar[XB_XCNT(j)]); sum += c; cnt += (c > 0u) ? 1u : 0u; mine = (j == x) ? c : mine; }
        if (sum == G) break;
        __builtin_amdgcn_s_sleep(1);
        if ((++sp & 255u) == 0u) { if (xb_ld(&bar[XB_TMO])) break; if (sp > XB_SPIN_CAP) { atomicAdd(&bar[XB_TMO], 1u); break; } }
    }
    nloc = mine > 0u ? mine : 1u; nx = cnt > 0u ? cnt : 1u;
}

__device__ __forceinline__ void xcd_barrier(const XcdBarrier& b) {
    asm volatile("s_waitcnt vmcnt(0)" ::: "memory");
    __syncthreads();
    if (threadIdx.x == 0) {
        unsigned* bar = b.bar;
        __builtin_amdgcn_s_waitcnt(0);
        unsigned nloc = b.st[0], nx = b.st[1];
        if (nloc == 0u) { xcd_barrier_complete(bar, b.x, nloc, nx); b.st[0] = nloc; b.st[1] = nx; }
        const unsigned old = xb_add(&bar[XB_XSUB(b.x)], 1u);
        const unsigned gen = old / nloc;
        if (old + 1u == (gen + 1u) * nloc) {
            __builtin_amdgcn_fence(__ATOMIC_RELEASE, "agent");
            asm volatile("s_waitcnt vmcnt(0)" ::: "memory");
            const unsigned og = xb_add(&bar[XB_TOP], 1u);
            const unsigned tg = og / nx;
            if (og + 1u == (tg + 1u) * nx) xb_add(&bar[XB_TOPGEN], 1u);
            else XB_SPIN(xb_ld(&bar[XB_TOPGEN]) == tg, bar);
            __builtin_amdgcn_fence(__ATOMIC_ACQUIRE, "agent");
            xb_add(&bar[XB_XGEN(b.x)], 1u);
            asm volatile("s_waitcnt vmcnt(0)" ::: "memory");
        } else {
            XB_SPIN(xb_ld(&bar[XB_XGEN(b.x)]) == gen, bar);
            __builtin_amdgcn_fence(__ATOMIC_ACQUIRE, "agent");
            asm volatile("s_waitcnt vmcnt(0)" ::: "memory");
        }
    }
    __syncthreads();
}

#ifndef PH_MAX
#define PH_MAX 99
#endif
typedef const __attribute__((address_space(4))) Args* KArgP;
#define PH_BEGIN { KArgP ap_ = kap; asm volatile("" : "+s"(ap_)); const Args a = *ap_; unsigned char* ws = a.ws; \
    int tid_ = threadIdx.x; asm volatile("" : "+v"(tid_)); const int tid = tid_, lane = tid & 63, wave = __builtin_amdgcn_readfirstlane(tid >> 6), gw = bid * 8 + wave, NGW = G * 8; \
    LAS float* scr = (LAS float*)(lds + wave * 16384); LAS float* xs = (LAS float*)(lds + XS_OFF); const float* RT = (const float*)(ws + WS_ROPE); \
    (void)tid; (void)lane; (void)gw; (void)NGW; (void)scr; (void)xs; (void)RT;
#define PH_END }
__global__ void __launch_bounds__(512, 2) mega(Args a_unused) {
#if defined(__HIP_DEVICE_COMPILE__)
    extern __shared__ __attribute__((aligned(16))) unsigned char lds_raw[];
    LAS unsigned char* lds = (LAS unsigned char*)lds_raw;
    cg::grid_group grid = cg::this_grid();
    const int G = gridDim.x, bid = blockIdx.x;
    const KArgP kap = (KArgP)__builtin_amdgcn_kernarg_segment_ptr();
    volatile LAS unsigned* bst = (volatile LAS unsigned*)(lds + LDS_BYTES - 64);
    if (threadIdx.x < 2) bst[threadIdx.x] = 0u;
    __syncthreads();

    if (G == 0x7fffffff) grid.sync();
    XcdBarrier xbar;
    { KArgP ap_ = kap; asm volatile("" : "+s"(ap_)); xbar = xcd_barrier_post((unsigned*)(ap_->ws + WS_CTR), bst); }
    PH_BEGIN phase0(a, lds, G); PH_END
    xcd_barrier(xbar);
    PH_BEGIN {
        pg8::Gemm g{(const bf16_t*)(ws + WS_E), (const bf16_t*)(ws + WS_D), MA, NIN, 2048, 2048, 2048};
        pg8::StaticOrder S; S.init(MA, NIN, G, bid); EpiZ E{ws};
        pg8::gemm_phase<EpiZ, pg8::StaticOrder, true, true>(lds, g, S, E);
    } PH_END
    xcd_barrier(xbar);
    PH_BEGIN phase2(a, lds, G); PH_END
    xcd_barrier(xbar);
    PH_BEGIN {
        const int nscan = G / 2;
        if (bid >= nscan) {
            pg8::Gemm g{(const bf16_t*)(ws + WS_ZMQ), (const bf16_t*)(ws + WS_WUQ), MA, 3072, 512, 512, 512};
            pg8::StaticOrder S; S.init(MA, 3072, G - nscan, bid - nscan);
            EpiHead E{(bf16_t*)(ws + WS_E), 2048, a.in[16], 8, (bf16_t*)(ws + WS_D), 1024, a.in[18], RT, xs, ATT_C};
            pg8::gemm_phase<EpiHead, pg8::StaticOrder, true, true>(lds, g, S, E);
        }
    } PH_END
    PH_BEGIN { __syncthreads(); const int nscan = G / 2; gla_phase(a, lds, bid < nscan ? bid : 128, nscan); } PH_END
    xcd_barrier(xbar);
    PH_BEGIN {
        {
            pg8::Gemm g{(const bf16_t*)(ws + WS_CKVALL), (const bf16_t*)(ws + WS_WUKV), MKV, 2048, 512, 512, 512};
            pg8::StaticOrder S; S.init(MKV, 2048, G, bid);
            EpiHead E{(bf16_t*)(ws + WS_KN), 2048, a.in[17], 8, nullptr, 0, nullptr, RT, xs, 1.0f};
            pg8::gemm_phase<EpiHead, pg8::StaticOrder, true, true>(lds, g, S, E);
        }
        {
            pg8::Gemm g{(const bf16_t*)(ws + WS_WUKV) + (size_t)2048 * 512, (const bf16_t*)(ws + WS_CKVALL), 2048, MKV, 512, 512, 512};
            pg8::StaticOrder S; S.init(2048, MKV, G, (bid + G - 8) % G);
            EpiVT E{(bf16_t*)(ws + WS_VT)};
            pg8::gemm_phase<EpiVT, pg8::StaticOrder, true, true>(lds, g, S, E);
        }
        gla_norm(a, G);
    } PH_END
    xcd_barrier(xbar);
    PH_BEGIN {
        attention_phase(a, lds, G);
        __syncthreads();
    } PH_END
    PH_BEGIN {
        transpose_matrix_q(a.in[11], 2048, 2048, 2048, (bf16_t*)(ws + WS_WBR), 4096, 0, nullptr, ScId(), gw, NGW, lane);
        transpose_matrix_q(a.in[20], 2048, 2048, 2048, (bf16_t*)(ws + WS_WBR), 4096, 2048, nullptr, ScId(), gw, NGW, lane);
        transpose_matrix_q(a.in[21], 2048, 2048, 2048, (bf16_t*)(ws + WS_WOUT), 2048, 0, nullptr, ScId(), gw, NGW, lane);
    } PH_END
    xcd_barrier(xbar);
    PH_BEGIN {
        pg8::Gemm g{(const bf16_t*)(a.out + O_Y), (const bf16_t*)(ws + WS_WBR), MP, 2048, 4096, 4096, 4096};
        pg8::StaticOrder S; S.init(MP, 2048, G, bid);
        EpiMerge E{(const bf16_t*)(ws + WS_ZGA), (const bf16_t*)(ws + WS_ZGB), (bf16_t*)(ws + WS_MB)};
        pg8::gemm_phase<EpiMerge, pg8::StaticOrder, true, true>(lds, g, S, E);
    } PH_END
    PH_BEGIN {
        int ksz = 256; asm volatile("" : "+s"(ksz));
        pg8::Gemm g{(const bf16_t*)(a.out + O_Y), (const bf16_t*)(ws + WS_WBR), MA, 2048, ksz, 4096, 4096};
        pg8::SplitOrder S{MP / 256, 8, 16, 256, G, bid};
        EpiPart E{(float*)(ws + WS_TA)};
        pg8::gemm_phase<EpiPart, pg8::SplitOrder, true, true>(lds, g, S, E);
    } PH_END
    xcd_barrier(xbar);
    PH_BEGIN {
        const float* P = (const float*)(ws + WS_TA); const bf16_t* GA = (const bf16_t*)(ws + WS_ZGA) + (size_t)MP * DM; const bf16_t* GB = (const bf16_t*)(ws + WS_ZGB) + (size_t)MP * DM;
        bf16_t* MBs = (bf16_t*)(ws + WS_MB) + (size_t)MP * DM;
        for (int i = bid * 512 + tid; i < 256 * DM / 4; i += G * 512) { f32x4 sa = {0.f, 0.f, 0.f, 0.f}, sb = sa;
#pragma unroll
            for (int k = 0; k < 8; ++k) { sa += __builtin_nontemporal_load((const f32x4*)(P + (size_t)k * 256 * DM + 4 * (size_t)i)); sb += __builtin_nontemporal_load((const f32x4*)(P + (size_t)(8 + k) * 256 * DM + 4 * (size_t)i)); }
            const u32x2 ga = *(const u32x2*)(GA + 4 * (size_t)i), gb = *(const u32x2*)(GB + 4 * (size_t)i);
            u32x2 o; o.x = pk2(sa[0] * sigmoidf_(bflo(ga.x)) + sb[0] * sigmoidf_(bflo(gb.x)), sa[1] * sigmoidf_(bfhi(ga.x)) + sb[1] * sigmoidf_(bfhi(gb.x)));
            o.y = pk2(sa[2] * sigmoidf_(bflo(ga.y)) + sb[2] * sigmoidf_(bflo(gb.y)), sa[3] * sigmoidf_(bfhi(ga.y)) + sb[3] * sigmoidf_(bfhi(gb.y)));
            *(u32x2*)(MBs + 4 * (size_t)i) = o; }
    } PH_END
    xcd_barrier(xbar);
    PH_BEGIN {
        pg8::Gemm g{(const bf16_t*)(ws + WS_MB), (const bf16_t*)(ws + WS_WOUT), MP, 2048, 2048, 2048, 2048};
        pg8::StaticOrder S; S.init(MP, 2048, G, bid);
        EpiX1 E{a.in[0], a.in[1], a.out + O_Y, (bf16_t*)(ws + WS_E), (float*)(ws + WS_SUMSQ)};
        pg8::gemm_phase<EpiX1, pg8::StaticOrder, true, true>(lds, g, S, E);
    } PH_END
    PH_BEGIN {
        int ksz = 256; asm volatile("" : "+s"(ksz));
        pg8::Gemm g{(const bf16_t*)(ws + WS_MB), (const bf16_t*)(ws + WS_WOUT), MA, 2048, ksz, 2048, 2048};
        pg8::SplitOrder S{MP / 256, 8, 8, 256, G, bid};
        EpiPart E{(float*)(ws + WS_TA) + (size_t)16 * 256 * DM};
        pg8::gemm_phase<EpiPart, pg8::SplitOrder, true, true>(lds, g, S, E);
        __syncthreads();
        transpose_matrix_q(a.in[23], 2048, 2 * DFF, 2 * DFF, (bf16_t*)(ws + WS_WUP), 2048, 0, a.in[22], ScUp(), gw, NGW, lane);
    } PH_END
    xcd_barrier(xbar);
    PH_BEGIN {
        const float* P = (const float*)(ws + WS_TA) + (size_t)16 * 256 * DM; float* SS = (float*)(ws + WS_SUMSQ); bf16_t* X1B = (bf16_t*)(ws + WS_E);
        for (int r = gw; r < 256; r += NGW) { float ss = 0.f;
#pragma unroll
            for (int j = 0; j < 8; ++j) { const size_t o = (size_t)r * DM + 4 * lane + 256 * j; f32x4 v = *(const f32x4*)(a.in[1] + o);
#pragma unroll
                for (int k = 0; k < 8; ++k) v += __builtin_nontemporal_load((const f32x4*)(P + (size_t)k * 256 * DM + o));
                *(f32x4*)(a.out + O_Y + (size_t)MP * DM + o) = v;
                u32x2 w; w.x = pk2(v[0], v[1]); w.y = pk2(v[2], v[3]); *(u32x2*)(X1B + (size_t)MP * DM + o) = w;
                ss += (v[0] * v[0] + v[1] * v[1]) + (v[2] * v[2] + v[3] * v[3]); }
            ss = wave_sum(ss); if (lane == 0) SS[MP + r] = ss; }
    } PH_END
    xcd_barrier(xbar);
    PH_BEGIN {
        pg8::Gemm g{(const bf16_t*)(ws + WS_E), (const bf16_t*)(ws + WS_WUP), MA, 2 * DFF, 2048, 2048, 2048};
        pg8::StaticOrder S; S.init(MA, 2 * DFF, G, bid);
        EpiUpG E{(bf16_t*)(ws + WS_G), (const float*)(ws + WS_SUMSQ), a.out, a.in[24], a.in[25], a.in[5], (float*)(ws + WS_SIDE)};
        pg8::gemm_phase<EpiUpG, pg8::StaticOrder, true, true>(lds, g, S, E);
    } PH_END
    PH_BEGIN {
        const int rem = ((MA / 256) * (2 * DFF / 256)) % G, first = rem, nearly = G - rem;
        if (bid >= first) { const int nblk = 2048 / 32, nit = (DFF / 64) * nblk;
            for (int it = (bid - first) * 8 + wave; it < nit; it += nearly * 8) transpose_item_q(a.in[26], 2048, (bf16_t*)(ws + WS_WDOWN), DFF, 0, it / nblk, it % nblk, lane, nullptr, ScId()); }
    } PH_END
    xcd_barrier(xbar);
    PH_BEGIN {
        const float* AH = (const float*)(ws + WS_SIDE); const float* AF0 = AH + 33 * 8 * DFF; const float* GT0 = AH + 2 * 33 * 8 * DFF;
        const float* cw = a.in[24]; const float* cb = a.in[25]; bf16_t* Gb = (bf16_t*)(ws + WS_G);
        for (int i = bid * 512 + tid; i < 32 * 8 * DFF; i += G * 512) { const int c = i % DFF, q = i / DFF, rr = q & 1, pb = q >> 1, pm = pb >> 2, blk = pb & 3;
            const float a0 = AF0[((size_t)pb * 2 + rr) * DFF + c], gt = GT0[((size_t)pb * 2 + rr) * DFF + c];
            const bool start = blk == 0 && (pm == 0 || pm == TP / 256);
            const float h1 = start ? 0.f : AH[((size_t)(pb - 1) * 2 + 1) * DFF + c], h0 = start ? 0.f : AH[((size_t)(pb - 1) * 2) * DFF + c];
            const float a1 = rr == 0 ? h1 : AF0[((size_t)pb * 2) * DFF + c];
            const float a2 = rr == 0 ? h0 : h1;
            const float cv = cb[c] + cw[2 * DFF + c] * a0 + cw[DFF + c] * a1 + cw[c] * a2;
            f32x2 v2; v2.x = cv; v2.y = 0.f; const f32x2 ge = gelu_pk(v2);
            Gb[(size_t)(pm * 256 + blk * 64 + rr) * DFF + c] = (bf16_t)(pk2(ge.x * gt, 0.f) & 0xffffu); }
    } PH_END
    PH_BEGIN {
        int ksz = 256; asm volatile("" : "+s"(ksz));
        pg8::Gemm g{(const bf16_t*)(ws + WS_G), (const bf16_t*)(ws + WS_WDOWN), MA, 2048, ksz, DFF, DFF};
        pg8::SplitOrder S{MP / 256, 8, DFF / 256, 256, G, bid};
        EpiPart E{(float*)(ws + WS_PART)};
        __syncthreads();
        pg8::gemm_phase<EpiPart, pg8::SplitOrder, true, true>(lds, g, S, E);
    } PH_END
    xcd_barrier(xbar);
    PH_BEGIN {
        {
            const float* P = (const float*)(ws + WS_PART); float* Y = a.out + O_Y + (size_t)MP * DM;
            for (int i = bid * 512 + tid; i < 256 * DM / 4; i += G * 512) { f32x4 s = *(const f32x4*)(Y + 4 * (size_t)i);
#pragma unroll
                for (int k = 0; k < DFF / 256; ++k) s += __builtin_nontemporal_load((const f32x4*)(P + (size_t)k * 256 * DM + 4 * (size_t)i));
                *(f32x4*)(Y + 4 * (size_t)i) = s; }
        }
        {
            pg8::Gemm g{(const bf16_t*)(ws + WS_G), (const bf16_t*)(ws + WS_WDOWN), MP, 2048, DFF, DFF, DFF};
            pg8::StaticOrder S; S.init(MP, 2048, G, bid);
            EpiY E{a.out + O_Y};
            pg8::gemm_phase<EpiY, pg8::StaticOrder, true, true>(lds, g, S, E);
        }
    } PH_END
#endif
}

extern "C" void kernel_launch(void* const* d_in, const int* in_sizes, int n_in, void* d_out, int out_size, void* d_ws, size_t ws_size, hipStream_t stream) {
    static int grid = 0;
    if (grid == 0) {
        if (n_in != 27 || ws_size < WS_END || out_size != (int)O_END) { fprintf(stderr, "kernel_launch: unexpected problem: n_in %d ws %zu out %d\n", n_in, ws_size, out_size); grid = -1; return; }
        int dev = 0, cus = 0, per_cu = 0;
        (void)hipGetDevice(&dev); (void)hipDeviceGetAttribute(&cus, hipDeviceAttributeMultiprocessorCount, dev);
        (void)hipFuncSetAttribute((const void*)mega, hipFuncAttributeMaxDynamicSharedMemorySize, LDS_BYTES);
        (void)hipOccupancyMaxActiveBlocksPerMultiprocessor(&per_cu, (const void*)mega, 512, LDS_BYTES);
        if (per_cu < 1) { fprintf(stderr, "kernel_launch: occupancy query says %d blocks/CU\n", per_cu); grid = -1; return; }
        grid = cus;
    }
    if (grid < 0) return;
    if (hipMemsetAsync((unsigned char*)d_ws + WS_CTR, 0, 16384, stream) != hipSuccess) { fprintf(stderr, "kernel_launch: memset of the barrier words failed\n"); return; }
    Args a{};
    for (int i = 0; i < 27; ++i) a.in[i] = (const float*)d_in[i];
    a.out = (float*)d_out; a.ws = (unsigned char*)d_ws;
    void* args[] = {&a};
    hipError_t e = hipLaunchCooperativeKernel((const void*)mega, dim3(grid), dim3(512), args, LDS_BYTES, stream);
    if (e != hipSuccess) fprintf(stderr, "cooperative launch failed: %s (grid %d)\n", hipGetErrorString(e), grid);
}
```

```cpp
#include <hip/hip_runtime.h>
#include <hip/hip_cooperative_groups.h>
#include <cstdio>
#include <cstdint>
#include <cmath>
namespace cg = cooperative_groups;

namespace pg8 {
#define PG8_LAS __attribute__((address_space(3)))
typedef unsigned short bf16_t;
typedef short bf16x8 __attribute__((ext_vector_type(8)));
typedef float f32x4 __attribute__((ext_vector_type(4)));
typedef unsigned u32x4 __attribute__((ext_vector_type(4)));
constexpr int BM = 256, BK = 64, HALF = 128, HTB = HALF * BK * 2  , STAGE_BYTES = 8 * HTB, NXCD = 8, WGM = 8;

__host__ __device__ __forceinline__ int lds_byte(int r, int c) { const int st = (r >> 4) * 2 + (c >> 5), rr = r & 15, cc = c & 31, ob = rr * 64 + cc * 2; return st * 1024 + (ob ^ (((ob >> 9) & 1) << 5)); }
__host__ __device__ __forceinline__ void stage_rc(int b, int& R, int& C) { const int st = b / 1024, sb = b % 1024, swz = sb ^ (((sb >> 9) & 1) << 5); R = (st >> 1) * 16 + swz / 64; C = (st & 1) * 32 + (swz % 64) / 2; }
__host__ __device__ __forceinline__ int perm32(int rho) { const int n = rho >> 4, i = rho & 15; return 8 * (i >> 2) + 4 * n + (i & 3); }

struct Unit { int pm, pn, kofs; };
struct Gemm { const bf16_t* A; const bf16_t* Bt; int M, N, K, lda, ldb; };

struct StaticOrder {
    int nM, nN, nwg, G, c;
    __host__ __device__ void init(int M, int N, int G_, int c_) { nM = M / BM; nN = N / BM; nwg = nM * nN; G = G_; c = c_; }
    __host__ __device__ bool next(int i, Unit& u) const {
        const long L = (long)i * G + c; if (L >= nwg) return false;
        int wgid = (int)L; { const int q = nwg / NXCD, r = nwg % NXCD, xcd = wgid % NXCD, off = wgid / NXCD; wgid = (xcd < r ? xcd * (q + 1) : r * (q + 1) + (xcd - r) * q) + off; }
        const int nig = WGM * nN, gid = wgid / nig, fm = gid * WGM, gsz = (nM - fm) < WGM ? (nM - fm) : WGM;
        u.pm = fm + ((wgid % nig) % gsz); u.pn = (wgid % nig) / gsz; u.kofs = 0; return true;
    }
    __device__ __forceinline__ void a_ready(const Unit&) const {}
    __device__ __forceinline__ void done(const Unit&) const {}
};
struct SplitOrder {
    int pm, nN, nsplit, ksz, G, c;
    __device__ __forceinline__ bool next(int i, Unit& u) const { const int L = i * G + c; if (L >= nN * nsplit) return false; u.pm = pm; u.pn = L % nN; u.kofs = (L / nN) * ksz; return true; }
    __device__ __forceinline__ void a_ready(const Unit&) const {}
    __device__ __forceinline__ void done(const Unit&) const {}
};
__device__ __forceinline__ unsigned cvt_pk_bf16(float lo, float hi) { unsigned r; asm volatile("v_cvt_pk_bf16_f32 %0, %1, %2" : "=v"(r) : "v"(lo), "v"(hi)); return r; }

template <class Epi, class Sched, bool ALIGN_EPI = false, bool SP2 = false>
__device__ __forceinline__ void gemm_phase(PG8_LAS unsigned char* lds, const Gemm g, const Sched& S, const Epi& E) {
    int tid_ = threadIdx.x; asm volatile("" : "+v"(tid_)); const int tid = tid_, wid = __builtin_amdgcn_readfirstlane(tid >> 6), lane = tid & 63, wr = wid >> 2, wc = wid & 3, fr = lane & 15, fq = lane >> 4;
    const int K = g.K, nt = K / BK;
    unsigned voffA[2], voffB[2];
#pragma unroll
    for (int i = 0; i < 2; ++i) { int R, C; stage_rc(tid * 16 + i * 8192, R, C); const int Rb = Epi::PERM ? ((R & ~31) + perm32(R & 31)) : R;
        voffA[i] = (unsigned)(R * g.lda + C) * 2u; voffB[i] = (unsigned)(Rb * g.ldb + C) * 2u; }
    const size_t kstep = (size_t)(BK * 2);
    const size_t hstepA = (size_t)HALF * g.lda * 2, hstepB = (size_t)HALF * g.ldb * 2;
    const size_t tstepA = 2 * hstepA, tstepB = 2 * hstepB;
    const unsigned ldsw = (unsigned)wid * 1024u;
    const int aoff = lds_byte(wr * 64 + fr, fq * 8), boff = lds_byte(wc * 32 + fr, fq * 8);
#define PG8_SA(b, h) (((b) * 2 + (h)) * HTB)
#define PG8_SB(b, h) ((4 + (b) * 2 + (h)) * HTB)
#define PG8_STAGE(bufoff, gbase, voff) do { _Pragma("unroll") for (int _i = 0; _i < 2; ++_i) \
        __builtin_amdgcn_global_load_lds((const unsigned*)((const char*)(gbase) + (voff)[_i]), (PG8_LAS unsigned*)(lds + (bufoff) + ldsw + _i * 8192), 16, 0, 0); } while (0)
#define PG8_LDA(dst, b, h) do { _Pragma("unroll") for (int m = 0; m < 4; ++m) _Pragma("unroll") for (int k = 0; k < 2; ++k) dst[m][k] = *(const PG8_LAS bf16x8*)(lds + PG8_SA(b, h) + aoff + m * 2048 + k * 1024); } while (0)
#define PG8_LDB(dst, b, h) do { _Pragma("unroll") for (int n = 0; n < 2; ++n) _Pragma("unroll") for (int k = 0; k < 2; ++k) dst[n][k] = *(const PG8_LAS bf16x8*)(lds + PG8_SB(b, h) + boff + n * 2048 + k * 1024); } while (0)
#define PG8_MMA(ai, bj, At, Bt) do { __builtin_amdgcn_s_setprio(1); _Pragma("unroll") for (int m = 0; m < 4; ++m) _Pragma("unroll") for (int n = 0; n < 2; ++n) _Pragma("unroll") for (int k = 0; k < 2; ++k) \
        acc[ai][bj][m][n] = __builtin_amdgcn_mfma_f32_16x16x32_bf16(Bt[n][k], At[m][k], acc[ai][bj][m][n], 0, 0, 0); __builtin_amdgcn_s_setprio(0); } while (0)
#define PG8_WAIT_V(n) asm volatile("s_waitcnt vmcnt(" #n ")" ::: "memory")
#define PG8_WAIT_L(n) asm volatile("s_waitcnt lgkmcnt(" #n ")" ::: "memory")
#define PG8_BAR __builtin_amdgcn_s_barrier()
#define PG8_SCHED __builtin_amdgcn_sched_barrier(0)
    Unit cur, nxt; int ui = 0;
    if (!S.next(0, cur)) return;
    f32x4 acc[2][2][4][2];
#pragma unroll
    for (int a = 0; a < 2; ++a)
#pragma unroll
        for (int b = 0; b < 2; ++b)
#pragma unroll
            for (int m = 0; m < 4; ++m)
#pragma unroll
                for (int n = 0; n < 2; ++n) acc[a][b][m][n] = (f32x4){0.f, 0.f, 0.f, 0.f};
    bf16x8 At[4][2], B0[2][2], B1[2][2];
    const char* cA = (const char*)g.A + (size_t)cur.pm * tstepA + (size_t)cur.kofs * 2; const char* cB = (const char*)g.Bt + (size_t)cur.pn * tstepB + (size_t)cur.kofs * 2;
    S.a_ready(cur);
    if constexpr (SP2) {
        PG8_STAGE(PG8_SB(0, 0), cB, voffB); PG8_STAGE(PG8_SB(0, 1), cB + hstepB, voffB); PG8_STAGE(PG8_SA(0, 0), cA, voffA); PG8_STAGE(PG8_SA(0, 1), cA + hstepA, voffA);
        if (wr == 1) PG8_BAR;
        PG8_WAIT_V(2); PG8_BAR;
        PG8_STAGE(PG8_SB(1, 0), cB + kstep, voffB); PG8_STAGE(PG8_SA(1, 0), cA + kstep, voffA); PG8_STAGE(PG8_SB(1, 1), cB + hstepB + kstep, voffB);
        PG8_WAIT_V(6); PG8_BAR;
    } else {
        PG8_STAGE(PG8_SB(0, 0), cB, voffB); PG8_STAGE(PG8_SA(0, 0), cA, voffA); PG8_STAGE(PG8_SB(0, 1), cB + hstepB, voffB); PG8_STAGE(PG8_SA(0, 1), cA + hstepA, voffA);
        if (wr == 1) PG8_BAR;
        PG8_WAIT_V(4); PG8_BAR;
        PG8_STAGE(PG8_SB(1, 0), cB + kstep, voffB); PG8_STAGE(PG8_SA(1, 0), cA + kstep, voffA); PG8_STAGE(PG8_SB(1, 1), cB + hstepB + kstep, voffB);
        PG8_WAIT_V(6); PG8_BAR;
    }
    for (;;) {
        const bool has_next = S.next(ui + 1, nxt);
        const char* nA = has_next ? (const char*)g.A + (size_t)nxt.pm * tstepA + (size_t)nxt.kofs * 2 : cA; const char* nB = has_next ? (const char*)g.Bt + (size_t)nxt.pn * tstepB + (size_t)nxt.kofs * 2 : cB;
        for (int t = 0; t < nt; t += 2) {
            if constexpr (Epi::HAS_MID) { if (t == (nt >> 1)) E.mid(acc, cur, wr, wc, fr, fq); }
            const bool last = (t == nt - 2);
            const char* a1 = cA + (size_t)(t + 1) * kstep;
            const char* a2 = last ? nA : cA + (size_t)(t + 2) * kstep; const char* b2 = last ? nB : cB + (size_t)(t + 2) * kstep;
            const char* a3 = a2 + kstep; const char* b3 = b2 + kstep;
            if (last && has_next) S.a_ready(nxt);
            if constexpr (SP2) {
            PG8_LDB(B0, 0, 0); PG8_LDB(B1, 0, 1); PG8_SCHED; PG8_LDA(At, 0, 0); PG8_STAGE(PG8_SA(1, 1), a1 + hstepA, voffA);
            PG8_WAIT_V(8); PG8_WAIT_L(0); PG8_BAR; PG8_MMA(0, 0, At, B0); PG8_MMA(0, 1, At, B1); PG8_BAR; PG8_SCHED;
            PG8_LDA(At, 0, 1); PG8_STAGE(PG8_SB(0, 0), b2, voffB); PG8_STAGE(PG8_SB(0, 1), b2 + hstepB, voffB); PG8_STAGE(PG8_SA(0, 0), a2, voffA);
            PG8_WAIT_V(8); PG8_WAIT_L(0); PG8_BAR; PG8_MMA(1, 0, At, B0); PG8_MMA(1, 1, At, B1); PG8_BAR; PG8_SCHED;
            PG8_LDB(B0, 1, 0); PG8_LDB(B1, 1, 1); PG8_SCHED; PG8_LDA(At, 1, 0); PG8_STAGE(PG8_SA(0, 1), a2 + hstepA, voffA);
            PG8_WAIT_V(8); PG8_WAIT_L(0); PG8_BAR; PG8_MMA(0, 0, At, B0); PG8_MMA(0, 1, At, B1); PG8_BAR; PG8_SCHED;
            PG8_LDA(At, 1, 1); PG8_STAGE(PG8_SB(1, 0), b3, voffB); PG8_STAGE(PG8_SB(1, 1), b3 + hstepB, voffB); PG8_STAGE(PG8_SA(1, 0), a3, voffA);
            PG8_WAIT_V(8); PG8_WAIT_L(0); PG8_BAR; PG8_MMA(1, 0, At, B0); PG8_MMA(1, 1, At, B1); PG8_BAR; PG8_SCHED;
            } else {
            PG8_LDB(B0, 0, 0); PG8_SCHED; PG8_LDA(At, 0, 0); PG8_STAGE(PG8_SA(1, 1), a1 + hstepA, voffA);
            PG8_WAIT_L(8); PG8_BAR; PG8_WAIT_L(0); PG8_MMA(0, 0, At, B0); PG8_BAR; PG8_SCHED;
            PG8_LDB(B1, 0, 1); PG8_STAGE(PG8_SB(0, 0), b2, voffB);
            PG8_BAR; PG8_WAIT_L(0); PG8_MMA(0, 1, At, B1); PG8_BAR;
            PG8_LDA(At, 0, 1); PG8_STAGE(PG8_SA(0, 0), a2, voffA);
            PG8_BAR; PG8_WAIT_L(0); PG8_MMA(1, 0, At, B0); PG8_BAR; PG8_SCHED;
            PG8_STAGE(PG8_SB(0, 1), b2 + hstepB, voffB);
            PG8_WAIT_V(6); PG8_BAR; PG8_MMA(1, 1, At, B1); PG8_BAR;
            PG8_LDB(B0, 1, 0); PG8_SCHED; PG8_LDA(At, 1, 0); PG8_STAGE(PG8_SA(0, 1), a2 + hstepA, voffA);
            PG8_WAIT_L(8); PG8_BAR; PG8_WAIT_L(0); PG8_MMA(0, 0, At, B0); PG8_BAR; PG8_SCHED;
            PG8_LDB(B1, 1, 1); PG8_STAGE(PG8_SB(1, 0), b3, voffB);
            PG8_BAR; PG8_WAIT_L(0); PG8_MMA(0, 1, At, B1); PG8_BAR;
            PG8_LDA(At, 1, 1); PG8_STAGE(PG8_SA(1, 0), a3, voffA);
            PG8_BAR; PG8_WAIT_L(0); PG8_MMA(1, 0, At, B0); PG8_BAR; PG8_SCHED;
            PG8_STAGE(PG8_SB(1, 1), b3 + hstepB, voffB);
            PG8_WAIT_V(6); PG8_BAR; PG8_MMA(1, 1, At, B1); PG8_BAR;
            }
        }
        if constexpr (ALIGN_EPI) { if (wr == 0) PG8_BAR; }
        if constexpr (!Epi::AFTER_DRAIN) { E(acc, cur, wr, wc, fr, fq); S.done(cur); }
        if (!has_next) break;
#pragma unroll
        for (int a = 0; a < 2; ++a)
#pragma unroll
            for (int b = 0; b < 2; ++b)
#pragma unroll
                for (int m = 0; m < 4; ++m)
#pragma unroll
                    for (int n = 0; n < 2; ++n) acc[a][b][m][n] = (f32x4){0.f, 0.f, 0.f, 0.f};
        cur = nxt; cA = nA; cB = nB; ++ui;
        if constexpr (ALIGN_EPI) { if (wr == 1) PG8_BAR; }
    }
    PG8_WAIT_V(0);
    if constexpr (!ALIGN_EPI) { if (wr == 0) PG8_BAR; }
    PG8_BAR;
    if constexpr (Epi::AFTER_DRAIN) { E.fused(acc, cur, wr, wc, fr, fq, lds, wid, lane); S.done(cur); }
#undef PG8_SA
#undef PG8_SB
#undef PG8_STAGE
#undef PG8_LDA
#undef PG8_LDB
#undef PG8_MMA
#undef PG8_WAIT_V
#undef PG8_WAIT_L
#undef PG8_BAR
#undef PG8_SCHED
}
}

#define LAS __attribute__((address_space(3)))
typedef unsigned short bf16_t;
typedef short bf16x8 __attribute__((ext_vector_type(8)));
typedef float f32x4 __attribute__((ext_vector_type(4)));
typedef float f32x16 __attribute__((ext_vector_type(16)));
typedef unsigned u32x4 __attribute__((ext_vector_type(4)));
typedef unsigned u32x2 __attribute__((ext_vector_type(2)));

constexpr int DM = 2048, TP = 4096, MP = 8192, DBS = 16, DTS = 16, MA = 8448;
constexpr int PAST = 1024, KSS = 1040;
constexpr int MKV = MP + DBS * KSS;
constexpr int MKVP = MKV + 64;
constexpr int DFF = 5632, NIN = 11520, NCH = 144;
constexpr float EPS = 1e-6f;
constexpr int LDS_BYTES = 163840;
constexpr int XS_OFF = 131072;

constexpr size_t WS_SUMSQ = 0, WS_CTR = 40960, WS_EBL = 65536, WS_ROPE = 1048576;
constexpr size_t WS_WUQ = 2097152, WS_WUKV = 5242880, WS_CKVALL = 9437184, WS_KPEALL = 34930688;
constexpr size_t WS_E = 38117376;
constexpr size_t WS_ZV = 72720384, WS_ZR = 107323392, WS_ZGA = 141926400, WS_ZGB = 176529408;
constexpr size_t WS_D = 211132416;
constexpr size_t WS_ZQ = 258318336, WS_ZK = 275619840, WS_ZMQ = 292921344, WS_ZMKV = 301572096, WS_ZMISC = 310222848;
constexpr size_t WS_ZKT = 314548224, WS_AF = 331849728;
constexpr size_t WS_KN = 228433920, WS_VT = 330407936;
constexpr size_t WS_WBR = WS_ZV, WS_WOUT = WS_ZV + 16777216, WS_MB = WS_ZR;
constexpr size_t WS_TA = WS_KN;
constexpr size_t WS_WUP = 368561664, WS_WDOWN = 414699008, WS_END = 437767680;
constexpr size_t WS_U = WS_ZV, WS_G = 263036928, WS_SIDE = WS_ZV, WS_PART = WS_ZV + 33554432;
constexpr int VTP = MKVP;
constexpr size_t O_Y = 0, O_ST = 17301504, O_CKV = 26738688, O_KPE = 31064064, O_FCP = 31604736, O_FCS = 31627264, O_END = 31807488;

struct Args { const float* in[27]; float* out; unsigned char* ws; };

__device__ __forceinline__ unsigned pk2(float lo, float hi) { return pg8::cvt_pk_bf16(lo, hi); }
__device__ __forceinline__ float bf2f(unsigned short b) { return __uint_as_float((unsigned)b << 16); }
__device__ __forceinline__ float bflo(unsigned w) { return __uint_as_float(w << 16); }
__device__ __forceinline__ float bfhi(unsigned w) { return __uint_as_float(w & 0xffff0000u); }
__device__ __forceinline__ float wave_sum(float v) {
#pragma unroll
    for (int o = 1; o < 64; o <<= 1) v += __shfl_xor(v, o);
    return v;
}
#define LDS_WAIT() asm volatile("s_waitcnt lgkmcnt(0)" ::: "memory")
__device__ __forceinline__ void unpack8(const u32x4 w, float (&x)[8]) { x[0] = bflo(w.x); x[1] = bfhi(w.x); x[2] = bflo(w.y); x[3] = bfhi(w.y); x[4] = bflo(w.z); x[5] = bfhi(w.z); x[6] = bflo(w.w); x[7] = bfhi(w.w); }

struct ScId { __device__ __forceinline__ int operator()(int d) const { return d; } };
struct ScIn { __device__ __forceinline__ int operator()(int d) const {
    if (d < 4096) return d;
    if (d < 6144) return 4112 + (d - 4096);
    if (d < 8192) return 7248 + (d - 6144);
    if (d < 10240) return 9296 + (d - 8192);
    if (d < 10752) return 6160 + (d - 10240);
    if (d < 11264) return 6672 + (d - 10752);
    if (d < 11328) return 7184 + (d - 11264);
    if (d < 11344) return 4096 + (d - 11328);
    return -1; } };
struct ScUq { __device__ __forceinline__ int operator()(int d) const {
    if (d < 2048) return (d >> 7) * 192 + (d & 127);
    d -= 2048; const int h = d >> 6, p = d & 63; return h * 192 + 128 + (p & 1) * 32 + (p >> 1); } };
struct ScUkv { __device__ __forceinline__ int operator()(int d) const {
    if (d < 2048) return (d >> 7) * 256 + (d & 127);
    d -= 2048; return (d >> 7) * 256 + 128 + (d & 127); } };

struct ScUp { __device__ __forceinline__ int operator()(int d) const { const int pn = d >> 8, c = d & 255; return c < 128 ? pn * 128 + c : 5632 + pn * 128 + (c - 128); } };
template <class SC>
__device__ __forceinline__ void transpose_item(const float* __restrict__ W, int Nsrc, bf16_t* __restrict__ WT, int ldt, int koff, LAS float* scr, int kb, int nb, int lane, const float* __restrict__ kscale, SC sc) {
    const int k0 = 64 * kb, n0 = 32 * nb;
    const int scl = sc(n0 + (lane & 31));
#pragma unroll 8
    for (int i = 0; i < 32; ++i) { const int kk = 2 * i + (lane >> 5); float v = scl >= 0 ? __builtin_nontemporal_load(W + (size_t)(k0 + kk) * Nsrc + scl) : 0.f; if (kscale) v *= kscale[k0 + kk]; scr[kk * 33 + (lane & 31)] = v; }
    LDS_WAIT();
    const int c = lane & 7;
#pragma unroll
    for (int j = 0; j < 4; ++j) { const int n = (lane >> 3) + 8 * j; const LAS float* s = scr + (8 * c) * 33 + n;
        u32x4 o; o.x = pk2(s[0 * 33], s[1 * 33]); o.y = pk2(s[2 * 33], s[3 * 33]); o.z = pk2(s[4 * 33], s[5 * 33]); o.w = pk2(s[6 * 33], s[7 * 33]);
        *(u32x4*)(WT + (size_t)(n0 + n) * ldt + koff + k0 + 8 * c) = o; }
    LDS_WAIT();
}
template <class SC>
__device__ __forceinline__ void transpose_item_q(const float* __restrict__ W, int Nsrc, bf16_t* __restrict__ WT, int ldt, int koff, int kb, int nb, int lane, const float* __restrict__ kscale, SC sc) {
    const int nq = lane & 7, ko = lane >> 3, k0 = 64 * kb + 8 * ko, n0 = 32 * nb + 4 * nq;
    const int scl = sc(n0);
    f32x4 v[8];
#pragma unroll
    for (int i = 0; i < 8; ++i) v[i] = scl >= 0 ? __builtin_nontemporal_load((const f32x4*)(W + (size_t)(k0 + i) * Nsrc + scl)) : (f32x4){0.f, 0.f, 0.f, 0.f};
    if (kscale) { const f32x4 s0 = *(const f32x4*)(kscale + k0), s1 = *(const f32x4*)(kscale + k0 + 4);
#pragma unroll
        for (int i = 0; i < 4; ++i) { v[i] = v[i] * s0[i]; v[4 + i] = v[4 + i] * s1[i]; } }
#pragma unroll
    for (int j = 0; j < 4; ++j) { u32x4 o; o.x = pk2(v[0][j], v[1][j]); o.y = pk2(v[2][j], v[3][j]); o.z = pk2(v[4][j], v[5][j]); o.w = pk2(v[6][j], v[7][j]);
        *(u32x4*)(WT + (size_t)(n0 + j) * ldt + koff + k0) = o; }
}
template <class SC>
__device__ __forceinline__ void transpose_matrix_q(const float* W, int K, int Nsrc, int Ndst, bf16_t* WT, int ldt, int koff, const float* kscale, SC sc, int gw, int NGW, int lane) {
    const int nblk = Ndst / 32, nit = (K / 64) * nblk;
    for (int it = gw; it < nit; it += NGW) transpose_item_q(W, Nsrc, WT, ldt, koff, it / nblk, it % nblk, lane, kscale, sc);
}
template <class SC>
__device__ __forceinline__ void transpose_matrix(const float* W, int K, int Nsrc, int Ndst, bf16_t* WT, int ldt, int koff, const float* kscale, SC sc, LAS float* scr, int gw, int NGW, int lane) {
    const int nblk = Ndst / 32, nit = (K / 64) * nblk;
    for (int it = gw; it < nit; it += NGW) transpose_item(W, Nsrc, WT, ldt, koff, scr, it / nblk, it % nblk, lane, kscale, sc);
}

struct EpiZ {
    static constexpr bool PERM = true, AFTER_DRAIN = false, HAS_MID = false;
    unsigned char* ws;
    __device__ __forceinline__ void operator()(const pg8::f32x4 (&acc)[2][2][4][2], const pg8::Unit& u, int wr, int wc, int fr, int fq) const {
        const int pn = u.pn; size_t off; int ld, c0;
        if (pn < 4) { off = WS_ZQ; ld = 1024; c0 = pn * 256; }
        else if (pn < 8) { off = WS_ZK; ld = 1024; c0 = (pn - 4) * 256; }
        else if (pn < 16) { off = WS_ZV; ld = 2048; c0 = (pn - 8) * 256; }
        else if (pn < 24) { off = WS_ZR; ld = 2048; c0 = (pn - 16) * 256; }
        else if (pn < 32) { off = WS_ZGA; ld = 2048; c0 = (pn - 24) * 256; }
        else if (pn < 40) { off = WS_ZGB; ld = 2048; c0 = (pn - 32) * 256; }
        else if (pn < 42) { off = WS_ZMQ; ld = 512; c0 = (pn - 40) * 256; }
        else if (pn < 44) { off = WS_ZMKV; ld = 512; c0 = (pn - 42) * 256; }
        else { off = WS_ZMISC; ld = 256; c0 = 0; }
        bf16_t* base = (bf16_t*)(ws + off);
        const int row0 = u.pm * 256 + wr * 64 + fr, col0 = c0 + wc * 32 + 8 * fq;
#pragma unroll
        for (int ai = 0; ai < 2; ++ai)
#pragma unroll
            for (int m = 0; m < 4; ++m) { bf16_t* rowp = base + (size_t)(row0 + ai * 128 + m * 16) * ld + col0;
#pragma unroll
                for (int bj = 0; bj < 2; ++bj) { const pg8::f32x4 v0 = acc[ai][bj][m][0], v1 = acc[ai][bj][m][1];
                    u32x4 w; w.x = pk2(v0[0], v0[1]); w.y = pk2(v0[2], v0[3]); w.z = pk2(v1[0], v1[1]); w.w = pk2(v1[2], v1[3]);
                    *(u32x4*)(rowp + bj * 128) = w; } }
    }
};

__device__ __forceinline__ int kvrow(int m) { return m < MP ? m : MP + ((m - MP) >> 4) * KSS + PAST + ((m - MP) & 15); }
__device__ __forceinline__ int tokpos(int m) { return m < MP ? (m & (TP - 1)) : PAST + ((m - MP) & 15); }

__device__ __forceinline__ void phase0(const Args& a, LAS unsigned char* lds, int G) {
    int tid_ = threadIdx.x; asm volatile("" : "+v"(tid_)); const int tid = tid_, lane = tid & 63, wave = __builtin_amdgcn_readfirstlane(tid >> 6);
    const int gw = blockIdx.x * 8 + wave, NGW = G * 8;
    LAS float* scr = (LAS float*)(lds + wave * 16384);
    unsigned char* ws = a.ws;
    transpose_matrix_q(a.in[6], 2048, 11344, NIN, (bf16_t*)(ws + WS_D), 2048, 0, nullptr, ScIn(), gw, NGW, lane);
    transpose_matrix(a.in[13], 512, 3072, 3072, (bf16_t*)(ws + WS_WUQ), 512, 0, nullptr, ScUq(), scr, gw, NGW, lane);
    transpose_matrix_q(a.in[15], 512, 4096, 4096, (bf16_t*)(ws + WS_WUKV), 512, 0, nullptr, ScUkv(), gw, NGW, lane);
    {
        const float* g1 = a.in[7]; bf16_t* H1 = (bf16_t*)(ws + WS_E);
        for (int m = gw; m < MA; m += NGW) {
            const float* xr = m < MP ? a.in[0] + (size_t)m * DM : a.in[1] + (size_t)(m - MP) * DM;
            f32x4 v[8]; float ss = 0.f;
#pragma unroll
            for (int j = 0; j < 8; ++j) { v[j] = __builtin_nontemporal_load((const f32x4*)(xr + 4 * lane + 256 * j)); ss += (v[j].x * v[j].x + v[j].y * v[j].y) + (v[j].z * v[j].z + v[j].w * v[j].w); }
            ss = wave_sum(ss); const float rstd = 1.0f / sqrtf(ss * (1.f / 2048.f) + EPS);
            bf16_t* o = H1 + (size_t)m * DM;
#pragma unroll
            for (int j = 0; j < 8; ++j) { const f32x4 g = *(const f32x4*)(g1 + 4 * lane + 256 * j);
                u32x2 w; w.x = pk2(v[j].x * rstd * g.x, v[j].y * rstd * g.y); w.y = pk2(v[j].z * rstd * g.z, v[j].w * rstd * g.w);
                *(u32x2*)(o + 4 * lane + 256 * j) = w; }
        }
    }
    {
        bf16_t* CK = (bf16_t*)(ws + WS_CKVALL); bf16_t* KP = (bf16_t*)(ws + WS_KPEALL);
        for (int r = gw; r < DBS * PAST; r += NGW) {
            const int db = r >> 10, p = r & 1023; const size_t row = (size_t)MP + db * KSS + p;
            const float* src = a.in[3] + (size_t)r * 512 + 8 * lane;
            const f32x4 x0 = __builtin_nontemporal_load((const f32x4*)src), x1 = __builtin_nontemporal_load((const f32x4*)(src + 4));
            u32x4 w; w.x = pk2(x0.x, x0.y); w.y = pk2(x0.z, x0.w); w.z = pk2(x1.x, x1.y); w.w = pk2(x1.z, x1.w);
            *(u32x4*)(CK + row * 512 + 8 * lane) = w;
            if (lane < 32) { const float* ks = a.in[4] + (size_t)r * 64; *(unsigned*)(KP + row * 64 + 2 * lane) = pk2(ks[lane], ks[32 + lane]); }
        }
    }
    {
        float* RT = (float*)(ws + WS_ROPE); const int gt = blockIdx.x * 512 + tid, NT = G * 512;
        for (int idx = gt; idx < 4096 * 32; idx += NT) { const int pos = idx >> 5, i = idx & 31;
            const float inv = exp2f(-(float)(2 * i) * (1.f / 64.f) * 13.287712379549449f);
            const float ang = (float)pos * inv; double rev = (double)ang * 0.15915494309189535; rev -= floor(rev); const float rv = (float)rev;
            RT[2 * idx] = __builtin_amdgcn_cosf(rv); RT[2 * idx + 1] = __builtin_amdgcn_sinf(rv); }
        float* SS = (float*)(ws + WS_SUMSQ);
        for (int i = gt; i < MA; i += NT) SS[i] = 0.f;
    }
}

__device__ __forceinline__ int crow(int r, int hi) { return (r & 3) + 8 * (r >> 2) + 4 * hi; }

__device__ __forceinline__ void phase2(const Args& a, LAS unsigned char* lds, int G) {
    int tid_ = threadIdx.x; asm volatile("" : "+v"(tid_)); const int tid = tid_, lane = tid & 63, wave = __builtin_amdgcn_readfirstlane(tid >> 6);
    unsigned char* ws = a.ws;
    bf16_t* ZQ = (bf16_t*)(ws + WS_ZQ); bf16_t* ZK = (bf16_t*)(ws + WS_ZK); bf16_t* ZMISC = (bf16_t*)(ws + WS_ZMISC);
    {
        LAS bf16_t* Qs = (LAS bf16_t*)lds; LAS bf16_t* Ks = (LAS bf16_t*)(lds + 66560);
        const float* w2 = a.in[8]; const float* bgp = a.in[9]; float* EBL = (float*)(ws + WS_EBL);
        bf16_t* ZKT = (bf16_t*)(ws + WS_ZKT); bf16_t* AF = (bf16_t*)(ws + WS_AF);
        for (int it = blockIdx.x; it < NCH * 2; it += G) {
            const int ci = it >> 1, half = it & 1, nrows = ci < 128 ? 64 : 16, row0 = ci < 128 ? ci * 64 : MP + (ci - 128) * 16;
            const int d = half * 512 + tid;
            float w2c[16];
#pragma unroll
            for (int r = 0; r < 16; ++r) w2c[r] = w2[r * 1024 + d];
            const float bg = bgp[d]; float b = 0.f;
#pragma unroll 8
            for (int t = 0; t < 64; ++t) {
                float qv = 0.f, kv = 0.f;
                if (t < nrows) {
                    const bf16_t* zm = ZMISC + (size_t)(row0 + t) * 256 + 64;
                    const u32x4 l0 = *(const u32x4*)zm, l1 = *(const u32x4*)(zm + 8);
                    float x = bg;
                    x += bflo(l0.x) * w2c[0] + bfhi(l0.x) * w2c[1] + bflo(l0.y) * w2c[2] + bfhi(l0.y) * w2c[3];
                    x += bflo(l0.z) * w2c[4] + bfhi(l0.z) * w2c[5] + bflo(l0.w) * w2c[6] + bfhi(l0.w) * w2c[7];
                    x += bflo(l1.x) * w2c[8] + bfhi(l1.x) * w2c[9] + bflo(l1.y) * w2c[10] + bfhi(l1.y) * w2c[11];
                    x += bflo(l1.z) * w2c[12] + bfhi(l1.z) * w2c[13] + bflo(l1.w) * w2c[14] + bfhi(l1.w) * w2c[15];
                    const float xc = fminf(fmaxf(x, -60.f), 60.f);
                    const float la2 = -__builtin_amdgcn_logf(1.0f + __builtin_amdgcn_exp2f(-xc * 1.4426950408889634f)) * 0.0625f;
                    b += la2; const float e = __builtin_amdgcn_exp2f(b), ei = __builtin_amdgcn_exp2f(-b);
                    const size_t o = (size_t)(row0 + t) * 1024 + d;
                    qv = bf2f(ZQ[o]) * 0.0625f * e; kv = bf2f(ZK[o]) * ei;
                }
                Qs[t * 520 + tid] = (bf16_t)(pk2(qv, 0.f) & 0xffffu); Ks[t * 520 + tid] = (bf16_t)(pk2(kv, 0.f) & 0xffffu);
            }
            EBL[ci * 1024 + d] = __builtin_amdgcn_exp2f(b);
            __syncthreads();
            if (wave < 6) {
                const int hh = wave / 3, tl = wave - 3 * hh, sb = tl == 2 ? 1 : 0, tb = tl == 0 ? 0 : 1, l32 = lane & 31, hi = lane >> 5;
                f32x16 acc = {};
                const LAS bf16_t* kp = Ks + (32 * sb + l32) * 520 + hh * 256 + 8 * hi; const LAS bf16_t* qp = Qs + (32 * tb + l32) * 520 + hh * 256 + 8 * hi;
#pragma unroll
                for (int ks = 0; ks < 16; ++ks) { const bf16x8 af = *(const LAS bf16x8*)(kp + 16 * ks), bfr = *(const LAS bf16x8*)(qp + 16 * ks);
                    acc = __builtin_amdgcn_mfma_f32_32x32x16_bf16(af, bfr, acc, 0, 0, 0); }
                unsigned w[8];
#pragma unroll
                for (int r = 0; r < 16; r += 2) { float v0 = acc[r], v1 = acc[r + 1];
                    if (tl != 1) { if (crow(r, hi) > l32) v0 = 0.f; if (crow(r + 1, hi) > l32) v1 = 0.f; }
                    w[r >> 1] = pk2(v0, v1); }
                bf16_t* dst = AF + ((size_t)((ci * 4 + 2 * half + hh) * 3 + tl) * 64 + lane) * 16;
                *(u32x4*)dst = (u32x4){w[0], w[1], w[2], w[3]}; *(u32x4*)(dst + 8) = (u32x4){w[4], w[5], w[6], w[7]};
            }
#pragma unroll
            for (int i = 0; i < 8; ++i) { const int c = tid + 512 * i, row = c >> 6, cc = c & 63, gi = cc >> 1, hi = cc & 1;
                if (row < nrows) { const LAS bf16_t* s = Qs + row * 520 + 16 * gi + 4 * hi;
                    const u32x2 lo = *(const LAS u32x2*)s, hi2 = *(const LAS u32x2*)(s + 8);
                    *(u32x4*)(ZQ + (size_t)(row0 + row) * 1024 + half * 512 + 8 * cc) = (u32x4){lo.x, lo.y, hi2.x, hi2.y}; } }
            for (int tg = 0; tg < nrows / 8; ++tg) { unsigned w[4];
#pragma unroll
                for (int j = 0; j < 4; ++j) w[j] = (unsigned)Ks[(8 * tg + 2 * j) * 520 + tid] | ((unsigned)Ks[(8 * tg + 2 * j + 1) * 520 + tid] << 16);
                *(u32x4*)(ZKT + (size_t)d * MA + row0 + 8 * tg) = (u32x4){w[0], w[1], w[2], w[3]}; }
            __syncthreads();
        }
    }
    {
        const int gw = blockIdx.x * 8 + wave, NGW = G * 8;
        bf16_t* ZMQ = (bf16_t*)(ws + WS_ZMQ); bf16_t* ZMKV = (bf16_t*)(ws + WS_ZMKV);
        bf16_t* CK = (bf16_t*)(ws + WS_CKVALL); bf16_t* KP = (bf16_t*)(ws + WS_KPEALL);
        const float* gq = a.in[12]; const float* gkv = a.in[14]; const float* gkp = a.in[19]; const float* RT = (const float*)(ws + WS_ROPE);
        float* CKO = a.out + O_CKV; float* KPO = a.out + O_KPE;
        for (int m = gw; m < MA; m += NGW) {
            {
                bf16_t* p = ZMQ + (size_t)m * 512 + 8 * lane; const u32x4 w = __builtin_nontemporal_load((const u32x4*)p);
                float x[8] = {bflo(w.x), bfhi(w.x), bflo(w.y), bfhi(w.y), bflo(w.z), bfhi(w.z), bflo(w.w), bfhi(w.w)};
                float ss = 0.f;
#pragma unroll
                for (int j = 0; j < 8; ++j) ss += x[j] * x[j];
                ss = wave_sum(ss); const float rstd = 1.0f / sqrtf(ss * (1.f / 512.f) + EPS);
                const f32x4 g0 = *(const f32x4*)(gq + 8 * lane), g1 = *(const f32x4*)(gq + 8 * lane + 4);
                u32x4 o; o.x = pk2(x[0] * rstd * g0.x, x[1] * rstd * g0.y); o.y = pk2(x[2] * rstd * g0.z, x[3] * rstd * g0.w);
                o.z = pk2(x[4] * rstd * g1.x, x[5] * rstd * g1.y); o.w = pk2(x[6] * rstd * g1.z, x[7] * rstd * g1.w);
                *(u32x4*)p = o;
            }
            const size_t kr = (size_t)kvrow(m);
            {
                const u32x4 w = __builtin_nontemporal_load((const u32x4*)(ZMKV + (size_t)m * 512 + 8 * lane));
                float x[8] = {bflo(w.x), bfhi(w.x), bflo(w.y), bfhi(w.y), bflo(w.z), bfhi(w.z), bflo(w.w), bfhi(w.w)};
                float ss = 0.f;
#pragma unroll
                for (int j = 0; j < 8; ++j) ss += x[j] * x[j];
                ss = wave_sum(ss); const float rstd = 1.0f / sqrtf(ss * (1.f / 512.f) + EPS);
                const f32x4 g0 = *(const f32x4*)(gkv + 8 * lane), g1 = *(const f32x4*)(gkv + 8 * lane + 4);
                const f32x4 y0 = {x[0] * rstd * g0.x, x[1] * rstd * g0.y, x[2] * rstd * g0.z, x[3] * rstd * g0.w};
                const f32x4 y1 = {x[4] * rstd * g1.x, x[5] * rstd * g1.y, x[6] * rstd * g1.z, x[7] * rstd * g1.w};
                *(f32x4*)(CKO + (size_t)m * 512 + 8 * lane) = y0; *(f32x4*)(CKO + (size_t)m * 512 + 8 * lane + 4) = y1;
                u32x4 o; o.x = pk2(y0.x, y0.y); o.y = pk2(y0.z, y0.w); o.z = pk2(y1.x, y1.y); o.w = pk2(y1.z, y1.w);
                *(u32x4*)(CK + kr * 512 + 8 * lane) = o;
            }
            {
                const bf16_t* zm = ZMISC + (size_t)m * 256; const int i = lane & 31;
                const float x1 = bf2f(zm[i]), x2 = bf2f(zm[32 + i]);
                float ss = lane < 32 ? x1 * x1 + x2 * x2 : 0.f; ss = wave_sum(ss); const float rstd = 1.0f / sqrtf(ss * (1.f / 64.f) + EPS);
                if (lane < 32) { const float y1 = x1 * rstd * gkp[i], y2 = x2 * rstd * gkp[32 + i];
                    const float c = RT[(tokpos(m) * 32 + i) * 2], s = RT[(tokpos(m) * 32 + i) * 2 + 1];
                    const float o1 = y1 * c - y2 * s, o2 = y2 * c + y1 * s;
                    KPO[(size_t)m * 64 + i] = o1; KPO[(size_t)m * 64 + 32 + i] = o2;
                    *(unsigned*)(KP + kr * 64 + 2 * i) = pk2(o1, o2); }
            }
        }
    }
}

struct EpiHead {
    static constexpr bool PERM = true, AFTER_DRAIN = false, HAS_MID = false;
    bf16_t* O0; int ld0; const float* gain0; int nsplit; bf16_t* O1; int ld1; const float* gain1; const float* RT; LAS float* xs; float oscale;
    __device__ __forceinline__ void operator()(const pg8::f32x4 (&acc)[2][2][4][2], const pg8::Unit& u, int wr, int wc, int fr, int fq) const {
#pragma unroll
        for (int ai = 0; ai < 2; ++ai)
#pragma unroll
            for (int m = 0; m < 4; ++m)
#pragma unroll
                for (int bj = 0; bj < 2; ++bj) { const pg8::f32x4 v0 = acc[ai][bj][m][0], v1 = acc[ai][bj][m][1];
                    float s = (v0[0] * v0[0] + v0[1] * v0[1]) + (v0[2] * v0[2] + v0[3] * v0[3]) + (v1[0] * v1[0] + v1[1] * v1[1]) + (v1[2] * v1[2] + v1[3] * v1[3]);
                    s += __shfl_xor(s, 16); s += __shfl_xor(s, 32);
                    if (fq == 0) xs[((ai * 128 + wr * 64 + m * 16 + fr) * 2 + bj) * 4 + wc] = s; __builtin_amdgcn_sched_barrier(0); }
        asm volatile("s_waitcnt lgkmcnt(0)" ::: "memory"); __builtin_amdgcn_s_barrier(); asm volatile("" ::: "memory");
        const bool rope = u.pn >= nsplit;
        int cl = wc * 32 + 8 * fq;
        asm volatile("" : "+v"(cl));
        if (!rope) {
            const pg8::f32x4 g0 = *(const pg8::f32x4*)(gain0 + cl), g1 = *(const pg8::f32x4*)(gain0 + cl + 4);
#pragma unroll
            for (int ai = 0; ai < 2; ++ai)
#pragma unroll
                for (int m = 0; m < 4; ++m) { const int rl = ai * 128 + wr * 64 + m * 16 + fr; bf16_t* rowp = O0 + (size_t)(u.pm * 256 + rl) * ld0 + u.pn * 256 + cl;
#pragma unroll
                    for (int bj = 0; bj < 2; ++bj) { const pg8::f32x4 p = *(const LAS pg8::f32x4*)(xs + (rl * 2 + bj) * 4);
                        const float rstd = oscale / sqrtf(((p[0] + p[1]) + (p[2] + p[3])) * (1.f / 128.f) + EPS);
                        const pg8::f32x4 v0 = acc[ai][bj][m][0] * rstd * g0, v1 = acc[ai][bj][m][1] * rstd * g1;
                        u32x4 w; w.x = pk2(v0[0], v0[1]); w.y = pk2(v0[2], v0[3]); w.z = pk2(v1[0], v1[1]); w.w = pk2(v1[2], v1[3]);
                        *(u32x4*)(rowp + bj * 128) = w; } __builtin_amdgcn_sched_barrier(0); }
        } else {
            const int p0 = cl & 63, i0 = p0 >> 1;
            float ga[8];
#pragma unroll
            for (int j = 0; j < 8; ++j) ga[j] = gain1[((p0 + j) & 1) * 32 + ((p0 + j) >> 1)];
#pragma unroll
            for (int ai = 0; ai < 2; ++ai)
#pragma unroll
                for (int m = 0; m < 4; ++m) { const int rl = ai * 128 + wr * 64 + m * 16 + fr, row = u.pm * 256 + rl;
                    bf16_t* rowp = O1 + (size_t)row * ld1 + (u.pn - nsplit) * 256 + cl;
                    const float* rt = RT + ((size_t)tokpos(row) * 32 + i0) * 2;
                    const pg8::f32x4 cs0 = *(const pg8::f32x4*)rt, cs1 = *(const pg8::f32x4*)(rt + 4);
#pragma unroll
                    for (int bj = 0; bj < 2; ++bj) { const pg8::f32x4 p = *(const LAS pg8::f32x4*)(xs + (rl * 2 + bj) * 4);
                        const float tot = wc < 2 ? p[0] + p[1] : p[2] + p[3];
                        const float rstd = oscale / sqrtf(tot * (1.f / 64.f) + EPS);
                        const pg8::f32x4 a0 = acc[ai][bj][m][0], a1 = acc[ai][bj][m][1];
                        const float y0 = a0[0] * rstd * ga[0], y1 = a0[1] * rstd * ga[1], y2 = a0[2] * rstd * ga[2], y3 = a0[3] * rstd * ga[3];
                        const float y4 = a1[0] * rstd * ga[4], y5 = a1[1] * rstd * ga[5], y6 = a1[2] * rstd * ga[6], y7 = a1[3] * rstd * ga[7];
                        u32x4 w;
                        w.x = pk2(y0 * cs0[0] - y1 * cs0[1], y1 * cs0[0] + y0 * cs0[1]);
                        w.y = pk2(y2 * cs0[2] - y3 * cs0[3], y3 * cs0[2] + y2 * cs0[3]);
                        w.z = pk2(y4 * cs1[0] - y5 * cs1[1], y5 * cs1[0] + y4 * cs1[1]);
                        w.w = pk2(y6 * cs1[2] - y7 * cs1[3], y7 * cs1[2] + y6 * cs1[3]);
                        *(u32x4*)(rowp + bj * 128) = w; } __builtin_amdgcn_sched_barrier(0); }
        }
    }
};
struct EpiVT {
    static constexpr bool PERM = false, AFTER_DRAIN = false, HAS_MID = false;
    bf16_t* O;
    __device__ __forceinline__ void operator()(const pg8::f32x4 (&acc)[2][2][4][2], const pg8::Unit& u, int wr, int wc, int fr, int fq) const {
        const int pos = (fq & 1) * 8 + (fq >> 1) * 4;
#pragma unroll
        for (int ai = 0; ai < 2; ++ai)
#pragma unroll
            for (int m = 0; m < 4; ++m) { bf16_t* rowp = O + (size_t)(u.pm * 256 + ai * 128 + wr * 64 + m * 16 + fr) * VTP + u.pn * 256 + wc * 32 + pos;
#pragma unroll
                for (int bj = 0; bj < 2; ++bj)
#pragma unroll
                    for (int n = 0; n < 2; ++n) { const pg8::f32x4 v = acc[ai][bj][m][n]; u32x2 w; w.x = pk2(v[0], v[1]); w.y = pk2(v[2], v[3]);
                        *(u32x2*)(rowp + bj * 128 + n * 16) = w; } }
    }
};
__device__ __forceinline__ float sigmoidf_(float x) { return 1.0f / (1.0f + __expf(-x)); }
struct EpiX1 {
    static constexpr bool PERM = true, AFTER_DRAIN = false, HAS_MID = false;
    const float* xp; const float* xs_; float* Y; bf16_t* X1B; float* SS;
    __device__ __forceinline__ void operator()(const pg8::f32x4 (&acc)[2][2][4][2], const pg8::Unit& u, int wr, int wc, int fr, int fq) const {
        const int row0 = u.pm * 256 + wr * 64 + fr, col0 = u.pn * 256 + wc * 32 + 8 * fq;
#pragma unroll
        for (int ai = 0; ai < 2; ++ai)
#pragma unroll
            for (int m = 0; m < 4; ++m) { const int row = row0 + ai * 128 + m * 16; const size_t ro = (size_t)row * DM + col0;
                const float* xr = row < MP ? xp + ro : xs_ + (ro - (size_t)MP * DM);
                float ss = 0.f;
#pragma unroll
                for (int bj = 0; bj < 2; ++bj) { const pg8::f32x4 x0 = __builtin_nontemporal_load((const pg8::f32x4*)(xr + bj * 128)), x1 = __builtin_nontemporal_load((const pg8::f32x4*)(xr + bj * 128 + 4));
                    const pg8::f32x4 o0 = x0 + acc[ai][bj][m][0], o1 = x1 + acc[ai][bj][m][1];
                    __builtin_nontemporal_store(o0, (pg8::f32x4*)(Y + ro + bj * 128)); __builtin_nontemporal_store(o1, (pg8::f32x4*)(Y + ro + bj * 128 + 4));
                    u32x4 w; w.x = pk2(o0[0], o0[1]); w.y = pk2(o0[2], o0[3]); w.z = pk2(o1[0], o1[1]); w.w = pk2(o1[2], o1[3]);
                    *(u32x4*)(X1B + ro + bj * 128) = w;
                    ss += (o0[0] * o0[0] + o0[1] * o0[1]) + (o0[2] * o0[2] + o0[3] * o0[3]) + (o1[0] * o1[0] + o1[1] * o1[1]) + (o1[2] * o1[2] + o1[3] * o1[3]); }
                ss += __shfl_xor(ss, 16); ss += __shfl_xor(ss, 32);
                if (fq == 0) unsafeAtomicAdd(SS + row, ss); }
    }
};
struct EpiY {
    static constexpr bool PERM = true, AFTER_DRAIN = false, HAS_MID = false;
    float* Y;
    __device__ __forceinline__ void operator()(const pg8::f32x4 (&acc)[2][2][4][2], const pg8::Unit& u, int wr, int wc, int fr, int fq) const {
        const int row0 = u.pm * 256 + wr * 64 + fr, col0 = u.pn * 256 + wc * 32 + 8 * fq;
#pragma unroll
        for (int ai = 0; ai < 2; ++ai)
#pragma unroll
            for (int m = 0; m < 4; ++m) { float* rp = Y + (size_t)(row0 + ai * 128 + m * 16) * DM + col0;
#pragma unroll
                for (int bj = 0; bj < 2; ++bj) { const pg8::f32x4 x0 = __builtin_nontemporal_load((const pg8::f32x4*)(rp + bj * 128)), x1 = __builtin_nontemporal_load((const pg8::f32x4*)(rp + bj * 128 + 4));
                    *(pg8::f32x4*)(rp + bj * 128) = x0 + acc[ai][bj][m][0]; *(pg8::f32x4*)(rp + bj * 128 + 4) = x1 + acc[ai][bj][m][1]; } }
    }
};

struct EpiPart {
    static constexpr bool PERM = true, AFTER_DRAIN = false, HAS_MID = false;
    float* P;
    __device__ __forceinline__ void operator()(const pg8::f32x4 (&acc)[2][2][4][2], const pg8::Unit& u, int wr, int wc, int fr, int fq) const {
        int row0 = wr * 64 + fr; const int col0 = u.pn * 256 + wc * 32 + 8 * fq;
        asm volatile("" : "+v"(row0));
        float* base = P + (size_t)(u.kofs >> 8) * 256 * DM;
#pragma unroll
        for (int ai = 0; ai < 2; ++ai)
#pragma unroll
            for (int m = 0; m < 4; ++m) { float* rp = base + (size_t)(row0 + ai * 128 + m * 16) * DM + col0;
#pragma unroll
                for (int bj = 0; bj < 2; ++bj) { __builtin_nontemporal_store(acc[ai][bj][m][0], (pg8::f32x4*)(rp + bj * 128)); __builtin_nontemporal_store(acc[ai][bj][m][1], (pg8::f32x4*)(rp + bj * 128 + 4)); } }
    }
};

struct EpiMerge {
    static constexpr bool PERM = true, AFTER_DRAIN = false, HAS_MID = true;
    const bf16_t* GA; const bf16_t* GB; bf16_t* MB;
    __device__ __forceinline__ void mid(pg8::f32x4 (&acc)[2][2][4][2], const pg8::Unit& u, int wr, int wc, int fr, int fq) const {
        int row0 = u.pm * 256 + wr * 64 + fr; const int col0 = u.pn * 256 + wc * 32 + 8 * fq;
        asm volatile("" : "+v"(row0));
#pragma unroll
        for (int ai = 0; ai < 2; ++ai)
#pragma unroll
            for (int m = 0; m < 4; ++m) { const size_t ro = (size_t)(row0 + ai * 128 + m * 16) * DM + col0;
#pragma unroll
                for (int bj = 0; bj < 2; ++bj) { const u32x4 ga = __builtin_nontemporal_load((const u32x4*)(GA + ro + bj * 128)), gb = *(const u32x4*)(GB + ro + bj * 128);
                    const float a[8] = {bflo(ga.x), bfhi(ga.x), bflo(ga.y), bfhi(ga.y), bflo(ga.z), bfhi(ga.z), bflo(ga.w), bfhi(ga.w)};
                    const float b[8] = {bflo(gb.x), bfhi(gb.x), bflo(gb.y), bfhi(gb.y), bflo(gb.z), bfhi(gb.z), bflo(gb.w), bfhi(gb.w)};
#pragma unroll
                    for (int j = 0; j < 8; ++j) { const float r = (1.0f + __expf(-b[j])) / (1.0f + __expf(-a[j])); acc[ai][bj][m][j >> 2][j & 3] *= r; } } }
    }
    __device__ __forceinline__ void operator()(const pg8::f32x4 (&acc)[2][2][4][2], const pg8::Unit& u, int wr, int wc, int fr, int fq) const {
        int row0 = u.pm * 256 + wr * 64 + fr; const int col0 = u.pn * 256 + wc * 32 + 8 * fq;
        asm volatile("" : "+v"(row0));
#pragma unroll
        for (int ai = 0; ai < 2; ++ai)
#pragma unroll
            for (int m = 0; m < 4; ++m) { const size_t ro = (size_t)(row0 + ai * 128 + m * 16) * DM + col0;
#pragma unroll
                for (int bj = 0; bj < 2; ++bj) { const u32x4 g = *(const u32x4*)(GB + ro + bj * 128);
                    const pg8::f32x4 a0 = acc[ai][bj][m][0], a1 = acc[ai][bj][m][1];
                    u32x4 w;
                    w.x = pk2(a0[0] * sigmoidf_(bflo(g.x)), a0[1] * sigmoidf_(bfhi(g.x)));
                    w.y = pk2(a0[2] * sigmoidf_(bflo(g.y)), a0[3] * sigmoidf_(bfhi(g.y)));
                    w.z = pk2(a1[0] * sigmoidf_(bflo(g.z)), a1[1] * sigmoidf_(bfhi(g.z)));
                    w.w = pk2(a1[2] * sigmoidf_(bflo(g.w)), a1[3] * sigmoidf_(bfhi(g.w)));
                    *(u32x4*)(MB + ro + bj * 128) = w; } }
    }
};

typedef float f32x2e __attribute__((ext_vector_type(2)));
__device__ __forceinline__ f32x2e gelu_pk2(f32x2e v) {
    const f32x2e av = __builtin_elementwise_abs(v), d = av * 0.2316418882f + 1.0f;
    f32x2e t; t.x = __builtin_amdgcn_rcpf(d.x); t.y = __builtin_amdgcn_rcpf(d.y);
    f32x2e q = t * 0.5307027145f + (-0.7265760135f); q = q * t + 0.7107068705f; q = q * t + (-0.142248368f); q = q * t + 0.127414796f; q = q * t;
    const f32x2e s = (v * v) * (-0.72134752044f);
    f32x2e e; e.x = __builtin_amdgcn_exp2f(s.x); e.y = __builtin_amdgcn_exp2f(s.y);
    const f32x2e m = v * (q * e), r = v - m;
    f32x2e o; o.x = v.x < 0.f ? m.x : r.x; o.y = v.y < 0.f ? m.y : r.y; return o;
}
__device__ __forceinline__ float dpp_shr1(float v, float old) { return __int_as_float(__builtin_amdgcn_update_dpp(__float_as_int(old), __float_as_int(v), 0x111, 0xf, 0xf, false)); }
__device__ __forceinline__ float dpp_shr2(float v, float old) { return __int_as_float(__builtin_amdgcn_update_dpp(__float_as_int(old), __float_as_int(v), 0x112, 0xf, 0xf, false)); }
struct EpiUpG {
    static constexpr bool PERM = true, AFTER_DRAIN = false, HAS_MID = false;
    bf16_t* Gb; const float* SS; float* out; const float* cw; const float* cb; const float* hist; float* side;
    __device__ __forceinline__ void operator()(const pg8::f32x4 (&acc)[2][2][4][2], const pg8::Unit& u, int wr, int wc, int fr, int fq) const {
        int cl = wc * 32 + 8 * fq; asm volatile("" : "+v"(cl));
        const int lane = fq * 16 + fr, col = u.pn * 128 + cl;
        const bool sample = u.pm == MP / 256;
        float* AH = side; float* AF0 = side + 33 * 8 * DFF; float* GT0 = side + 2 * 33 * 8 * DFF;
        float w0[8], w1[8], w2[8], wb[8];
#pragma unroll
        for (int j = 0; j < 8; j += 4) { const pg8::f32x4 t0 = *(const pg8::f32x4*)(cw + col + j), t1 = *(const pg8::f32x4*)(cw + DFF + col + j), t2 = *(const pg8::f32x4*)(cw + 2 * DFF + col + j), t3 = *(const pg8::f32x4*)(cb + col + j);
#pragma unroll
            for (int e = 0; e < 4; ++e) { w0[j + e] = t0[e]; w1[j + e] = t1[e]; w2[j + e] = t2[e]; wb[j + e] = t3[e]; } }
#pragma unroll
        for (int ai = 0; ai < 2; ++ai) {
            float prev[8];
#pragma unroll
            for (int e = 0; e < 8; ++e) prev[e] = 0.f;
#pragma unroll
            for (int m = 0; m < 4; ++m) {
                const int row_l = ai * 128 + wr * 64 + m * 16 + fr, row = u.pm * 256 + row_l, blk = ai * 2 + wr;
                const float rstd = 1.0f / sqrtf(SS[row] * (1.f / 2048.f) + EPS);
                float av[8], gv[8], b1[8], b2[8];
#pragma unroll
                for (int e = 0; e < 8; ++e) { av[e] = acc[ai][0][m][e >> 2][e & 3] * rstd; gv[e] = acc[ai][1][m][e >> 2][e & 3] * rstd; b1[e] = 0.f; b2[e] = 0.f; }
                if (sample) {
                    if (fr < 2) { const float* hp = hist + (size_t)(row_l >> 4) * 2 * DFF + col;
#pragma unroll
                        for (int e = 0; e < 8; ++e) { b1[e] = hp[DFF + e]; b2[e] = fr == 0 ? hp[e] : hp[DFF + e]; } }
                } else if (m > 0) {
#pragma unroll
                    for (int e = 0; e < 8; ++e) { b1[e] = __shfl(prev[e], (lane & 48) | 15); b2[e] = __shfl(prev[e], (lane & 48) | (14 + (fr & 1))); }
                }
                const bool defer = !sample && m == 0 && fr < 2;
                float y[8];
#pragma unroll
                for (int e = 0; e < 8; e += 2) {
                    const float a1x = dpp_shr1(av[e], b1[e]), a1y = dpp_shr1(av[e + 1], b1[e + 1]), a2x = dpp_shr2(av[e], b2[e]), a2y = dpp_shr2(av[e + 1], b2[e + 1]);
                    f32x2e cv; cv.x = wb[e] + w2[e] * av[e] + w1[e] * a1x + w0[e] * a2x;
                    cv.y = wb[e + 1] + w2[e + 1] * av[e + 1] + w1[e + 1] * a1y + w0[e + 1] * a2y;
                    const f32x2e ge = gelu_pk2(cv); y[e] = ge.x * gv[e]; y[e + 1] = ge.y * gv[e + 1]; }
                if (!defer) { u32x4 o; o.x = pk2(y[0], y[1]); o.y = pk2(y[2], y[3]); o.z = pk2(y[4], y[5]); o.w = pk2(y[6], y[7]);
                    *(u32x4*)(Gb + (size_t)row * DFF + col) = o; }
                else { float* pa_ = AF0 + ((size_t)(u.pm * 4 + blk) * 2 + fr) * DFF + col; float* pg_ = GT0 + ((size_t)(u.pm * 4 + blk) * 2 + fr) * DFF + col;
#pragma unroll
                    for (int e = 0; e < 8; ++e) { pa_[e] = av[e]; pg_[e] = gv[e]; } }
                if (m == 3 && fr >= 14) { float* ph = AH + ((size_t)(u.pm * 4 + blk) * 2 + (fr - 14)) * DFF + col;
#pragma unroll
                    for (int e = 0; e < 8; ++e) ph[e] = av[e]; }
                {
                    float* fc = nullptr;
                    if (row < MP) { const int t = row & (TP - 1); if (t >= TP - 2) fc = out + O_FCP + ((size_t)(row >> 12) * 2 + (t - (TP - 2))) * DFF + col; }
                    else { const int r = row - MP, t = r & 15; if (t >= 14) fc = out + O_FCS + ((size_t)(r >> 4) * 2 + (t - 14)) * DFF + col; }
                    if (fc) {
#pragma unroll
                        for (int e = 0; e < 8; ++e) fc[e] = av[e]; }
                }
#pragma unroll
                for (int e = 0; e < 8; ++e) prev[e] = av[e];
                __builtin_amdgcn_sched_barrier(0);
            }
        }
    }
};

constexpr int GS_Q = 0, GS_KT = 33792, GS_VT = 70656, GS_EB = 75264, GS_STAGE = 76288;
__device__ __forceinline__ bf16x8 pack8(const f32x16& v, int b) {
    u32x4 w; w.x = pk2(v[b], v[b + 1]); w.y = pk2(v[b + 2], v[b + 3]); w.z = pk2(v[b + 4], v[b + 5]); w.w = pk2(v[b + 6], v[b + 7]); return __builtin_bit_cast(bf16x8, w);
}
struct GlaStageRegs { u32x4 q[6], k[6]; u32x2 v[2]; u32x4 e; };
__device__ __forceinline__ void gla_stage_issue(const Args& a, GlaStageRegs& R, int hw, int lane, int rowc, int h, int vs, int ci, int nvalid) {
    asm volatile("" : "+v"(lane));
    unsigned char* ws = a.ws;
    const bf16_t* ZQ = (const bf16_t*)(ws + WS_ZQ); const bf16_t* ZKT = (const bf16_t*)(ws + WS_ZKT); const bf16_t* ZV = (const bf16_t*)(ws + WS_ZV); const float* EBL = (const float*)(ws + WS_EBL);
    const u32x4 z4 = {0u, 0u, 0u, 0u};
    R.e = z4;
#pragma unroll
    for (int i = 0; i < 6; ++i) { const int c = hw * 64 + lane + 384 * i; R.q[i] = z4; R.k[i] = z4;
        if (c < 2048) { const int row = c >> 5, cc = c & 31; if (row < nvalid) R.q[i] = *(const u32x4*)(ZQ + (size_t)(rowc + row) * 1024 + h * 256 + 8 * cc);
                        const int d = c >> 3, kc = c & 7; if (8 * kc < nvalid) R.k[i] = *(const u32x4*)(ZKT + (size_t)(h * 256 + d) * MA + rowc + 8 * kc); } }
#pragma unroll
    for (int i = 0; i < 2; ++i) { const int c = hw * 64 + lane + 384 * i; R.v[i] = (u32x2){0u, 0u};
        if (c < 512) { const int s = c >> 3, v4 = (c & 7) * 4; if (s < nvalid) R.v[i] = __builtin_nontemporal_load((const u32x2*)(ZV + (size_t)(rowc + s) * 2048 + h * 512 + vs * 32 + v4)); } }
    { const int c = hw * 64 + lane; if (c < 64) R.e = *(const u32x4*)(EBL + (size_t)ci * 1024 + h * 256 + 4 * c); }
}
__device__ __forceinline__ void gla_stage_commit(LAS unsigned char* st, const GlaStageRegs& R, int hw, int lane) {
    asm volatile("" : "+v"(lane));
#pragma unroll
    for (int i = 0; i < 6; ++i) { const int c = hw * 64 + lane + 384 * i;
        if (c < 2048) { *(LAS u32x4*)(st + GS_Q + (c >> 5) * 528 + (c & 31) * 16) = R.q[i]; *(LAS u32x4*)(st + GS_KT + (c >> 3) * 144 + (c & 7) * 16) = R.k[i]; } }
#pragma unroll
    for (int i = 0; i < 2; ++i) { const int c = hw * 64 + lane + 384 * i;
        if (c < 512) { const int s = c >> 3, v4 = (c & 7) * 4; LAS bf16_t* vt = (LAS bf16_t*)(st + GS_VT);
            vt[(v4 + 0) * 72 + s] = (bf16_t)(R.v[i].x & 0xffffu); vt[(v4 + 1) * 72 + s] = (bf16_t)(R.v[i].x >> 16); vt[(v4 + 2) * 72 + s] = (bf16_t)(R.v[i].y & 0xffffu); vt[(v4 + 3) * 72 + s] = (bf16_t)(R.v[i].y >> 16); } }
    { const int c = hw * 64 + lane; if (c < 64) *(LAS u32x4*)(st + GS_EB + c * 16) = R.e; }
}
__device__ __forceinline__ void gla_item(const Args& a, LAS unsigned char* lds, int it) {
    int tid_ = threadIdx.x; asm volatile("" : "+v"(tid_)); const int tid = tid_, lane = tid & 63, wave = __builtin_amdgcn_readfirstlane(tid >> 6), l32 = lane & 31, hi = lane >> 5;
    unsigned char* ws = a.ws;
    bf16_t* ZV = (bf16_t*)(ws + WS_ZV); const bf16_t* AF = (const bf16_t*)(ws + WS_AF);
    {
        int seq, h, vs, nchunk, row0, ci0, nvalid; const float* S0 = nullptr;
        if (it < 128) { seq = it >> 6; h = (it >> 4) & 3; vs = it & 15; nchunk = 64; row0 = seq * TP; ci0 = seq * 64; nvalid = 64; }
        else { const int j = it - 128, st = j >> 6; h = (j >> 4) & 3; vs = j & 15; seq = 2 + st; nchunk = 1; row0 = MP + st * 16; ci0 = 128 + st; nvalid = 16; S0 = a.in[2] + (size_t)((st * 4 + h) * 256) * 512; }
        float* SO = a.out + O_ST + (size_t)((seq * 4 + h) * 256) * 512;
        f32x16 S[4]; GlaStageRegs R;
        const int dw = wave * 4;
        if (wave < 2) {
#pragma unroll
            for (int db = 0; db < 4; ++db)
#pragma unroll
                for (int r = 0; r < 16; ++r) S[db][r] = S0 ? __builtin_nontemporal_load(S0 + (size_t)(32 * (dw + db) + crow(r, hi)) * 512 + vs * 32 + l32) : 0.f;
        } else { gla_stage_issue(a, R, wave - 2, lane, row0, h, vs, ci0, nvalid); gla_stage_commit(lds, R, wave - 2, lane);
                 if (nchunk > 1) gla_stage_issue(a, R, wave - 2, lane, row0 + 64, h, vs, ci0 + 1, nvalid); }
        if (threadIdx.x == 64) *(volatile LAS unsigned*)(lds + 2 * GS_STAGE + 8) = 0u;
        __syncthreads();
        LAS float* XO = (LAS float*)(lds + 2 * GS_STAGE + 16);
        volatile LAS unsigned* xflag = (volatile LAS unsigned*)(lds + 2 * GS_STAGE + 8);
        if (wave < 2) __builtin_amdgcn_s_setprio(3);
        for (int c = 0; c < nchunk; ++c) {
            LAS unsigned char* st = lds + (c & 1) * GS_STAGE;
            f32x16 o0 = {}, o1 = {};
            if (wave >= 2) { if (c + 1 < nchunk) { gla_stage_commit(lds + ((c + 1) & 1) * GS_STAGE, R, wave - 2, lane);
                                                   if (c + 2 < nchunk) gla_stage_issue(a, R, wave - 2, lane, row0 + 64 * (c + 2), h, vs, ci0 + c + 2, nvalid); } }
            else {
                int l32 = lane & 31, hi = lane >> 5; asm volatile("" : "+v"(l32), "+v"(hi));
                const LAS bf16_t* Qs = (const LAS bf16_t*)(st + GS_Q);
#pragma unroll
                for (int db = 0; db < 4; ++db)
#pragma unroll
                    for (int j = 0; j < 2; ++j) { const bf16x8 sf = pack8(S[db], 8 * j);
                        const bf16x8 q0 = *(const LAS bf16x8*)(Qs + l32 * 264 + 32 * (dw + db) + 16 * j + 8 * hi), q1 = *(const LAS bf16x8*)(Qs + (32 + l32) * 264 + 32 * (dw + db) + 16 * j + 8 * hi);
                        o0 = __builtin_amdgcn_mfma_f32_32x32x16_bf16(q0, sf, o0, 0, 0, 0); o1 = __builtin_amdgcn_mfma_f32_32x32x16_bf16(q1, sf, o1, 0, 0, 0);
                        __builtin_amdgcn_sched_barrier(0); }
                if (wave == 1) {
#pragma unroll
                    for (int r = 0; r < 16; ++r) { XO[r * 64 + lane] = o0[r]; XO[(16 + r) * 64 + lane] = o1[r]; }
                    asm volatile("s_waitcnt lgkmcnt(0)" ::: "memory");
                    if (lane == 0) xflag[0] = (unsigned)(c + 1);
                } else {
                    while (xflag[0] != (unsigned)(c + 1)) __builtin_amdgcn_s_sleep(1);
                    asm volatile("" ::: "memory");
                }
            }
            if (wave < 2) {
                int l32 = lane & 31, hi = lane >> 5; asm volatile("" : "+v"(l32), "+v"(hi));
                const LAS bf16_t* KT = (const LAS bf16_t*)(st + GS_KT); const LAS bf16_t* VT = (const LAS bf16_t*)(st + GS_VT);
                const LAS float* EB = (const LAS float*)(st + GS_EB);
                if (wave == 0) {
                    const int rowc = row0 + 64 * c;
#pragma unroll
                    for (int r = 0; r < 16; ++r) { o0[r] += XO[r * 64 + lane]; o1[r] += XO[(16 + r) * 64 + lane]; }
                    const bf16_t* afp = AF + ((size_t)((ci0 + c) * 4 + h) * 3 * 64 + lane) * 16;
                    bf16x8 af[3][2];
#pragma unroll
                    for (int tl = 0; tl < 3; ++tl) { af[tl][0] = *(const bf16x8*)(afp + (size_t)tl * 1024); af[tl][1] = *(const bf16x8*)(afp + (size_t)tl * 1024 + 8); }
#pragma unroll
                    for (int tl = 0; tl < 3; ++tl) { const int sb = tl == 2 ? 1 : 0;
#pragma unroll
                        for (int j = 0; j < 2; ++j) { const LAS bf16_t* vp = VT + l32 * 72 + 32 * sb + 16 * j + 4 * hi;
                            const u32x2 lo = *(const LAS u32x2*)vp, hi2 = *(const LAS u32x2*)(vp + 8);
                            const bf16x8 vf = __builtin_bit_cast(bf16x8, (u32x4){lo.x, lo.y, hi2.x, hi2.y});
                            if (tl == 0) o0 = __builtin_amdgcn_mfma_f32_32x32x16_bf16(af[tl][j], vf, o0, 0, 0, 0);
                            else o1 = __builtin_amdgcn_mfma_f32_32x32x16_bf16(af[tl][j], vf, o1, 0, 0, 0); } }
#pragma unroll
                    for (int r = 0; r < 16; ++r) { const int t = crow(r, hi);
                        if (t < nvalid) ZV[(size_t)(rowc + t) * 2048 + h * 512 + vs * 32 + l32] = (bf16_t)(pk2(o0[r], 0.f) & 0xffffu);
                        if (32 + t < nvalid) ZV[(size_t)(rowc + 32 + t) * 2048 + h * 512 + vs * 32 + l32] = (bf16_t)(pk2(o1[r], 0.f) & 0xffffu); }
                    __builtin_amdgcn_sched_barrier(0);
                }
#pragma unroll
                for (int db = 0; db < 4; ++db) { f32x16 acc = S[db];
#pragma unroll
                    for (int ks = 0; ks < 4; ++ks) { const bf16x8 kf = *(const LAS bf16x8*)(KT + (32 * (dw + db) + l32) * 72 + 16 * ks + 8 * hi), vf = *(const LAS bf16x8*)(VT + l32 * 72 + 16 * ks + 8 * hi);
                        acc = __builtin_amdgcn_mfma_f32_32x32x16_bf16(kf, vf, acc, 0, 0, 0); }
#pragma unroll
                    for (int q4 = 0; q4 < 4; ++q4) { const f32x4 e = *(const LAS f32x4*)(EB + 32 * (dw + db) + 8 * q4 + 4 * hi);
                        acc[4 * q4] *= e[0]; acc[4 * q4 + 1] *= e[1]; acc[4 * q4 + 2] *= e[2]; acc[4 * q4 + 3] *= e[3]; }
                    S[db] = acc; __builtin_amdgcn_sched_barrier(0); }
            }
            __syncthreads();
        }
        __builtin_amdgcn_s_setprio(0);
        if (wave < 2) {
#pragma unroll
            for (int db = 0; db < 4; ++db)
#pragma unroll
                for (int r = 0; r < 16; ++r) SO[(size_t)(32 * (dw + db) + crow(r, hi)) * 512 + vs * 32 + l32] = S[db][r];
        }
        __syncthreads();
    }
}
__device__ __forceinline__ void gla_phase(const Args& a, LAS unsigned char* lds, int chain, int nscan) {
    unsigned* ctr = (unsigned*)(a.ws + WS_CTR); volatile LAS unsigned* bc = (volatile LAS unsigned*)(lds + 2 * GS_STAGE);
    for (;;) {
        int it;
        if (chain < 128) { it = chain; chain += nscan; }
        else {
            if (threadIdx.x == 0) bc[0] = atomicAdd(ctr, 1u);
            __syncthreads();
            const unsigned j = bc[0];
            __syncthreads();
            if (j >= 1024u) break;
            it = 128 + (int)j;
        }
        gla_item(a, lds, it);
    }
}
__device__ __forceinline__ void gla_norm(const Args& a, int G) {
    int tid_ = threadIdx.x; asm volatile("" : "+v"(tid_)); const int tid = tid_, lane = tid & 63, wave = __builtin_amdgcn_readfirstlane(tid >> 6), gw = blockIdx.x * 8 + wave, NGW = G * 8;
    const bf16_t* ZV = (const bf16_t*)(a.ws + WS_ZV); const bf16_t* ZR = (const bf16_t*)(a.ws + WS_ZR); bf16_t* OG = (bf16_t*)(a.out + O_Y); const float* go = a.in[10];
    const f32x4 g0 = *(const f32x4*)(go + 8 * lane), g1 = *(const f32x4*)(go + 8 * lane + 4);
    const float gg[8] = {g0.x, g0.y, g0.z, g0.w, g1.x, g1.y, g1.z, g1.w};
    for (int it0 = gw; it0 < MA * 4; it0 += 4 * NGW) {
        u32x4 w[4], rr[4]; float ss[4];
#pragma unroll
        for (int u = 0; u < 4; ++u) { const int it = it0 + u * NGW; if (it < MA * 4) { const size_t o = (size_t)(it >> 2) * 2048 + (it & 3) * 512 + 8 * lane; w[u] = __builtin_nontemporal_load((const u32x4*)(ZV + o)); rr[u] = __builtin_nontemporal_load((const u32x4*)(ZR + o)); }
            else { w[u] = (u32x4){0u, 0u, 0u, 0u}; rr[u] = w[u]; } }
#pragma unroll
        for (int u = 0; u < 4; ++u) { float x[8]; unpack8(w[u], x); float s_ = 0.f;
#pragma unroll
            for (int j = 0; j < 8; ++j) s_ += x[j] * x[j];
            ss[u] = s_; }
#pragma unroll
        for (int o_ = 1; o_ < 64; o_ <<= 1) {
#pragma unroll
            for (int u = 0; u < 4; ++u) ss[u] += __shfl_xor(ss[u], o_); }
#pragma unroll
        for (int u = 0; u < 4; ++u) { const int it = it0 + u * NGW; if (it < MA * 4) { const int m = it >> 2, h = it & 3;
            float x[8], r[8]; unpack8(w[u], x); unpack8(rr[u], r);
            const float rstd = 1.0f / sqrtf(ss[u] * (1.f / 512.f) + EPS);
            float y[8];
#pragma unroll
            for (int j = 0; j < 8; ++j) y[j] = x[j] * rstd * gg[j] * (r[j] / (1.0f + __expf(-r[j])));
            u32x4 ow; ow.x = pk2(y[0], y[1]); ow.y = pk2(y[2], y[3]); ow.z = pk2(y[4], y[5]); ow.w = pk2(y[6], y[7]);
            *(u32x4*)(OG + (size_t)m * 4096 + h * 512 + 8 * lane) = ow; } }
    }
}

constexpr float ATT_C = 0.07216878364870322f * 1.4426950408889634f;
template <class KF, class VF>
__device__ __forceinline__ void attn_tile(const bf16x8 (&qf)[12], float& l, f32x16 (&o)[4], const KF& kf, const VF& vf, int nvalid, int hi) {
    f32x16 p0 = {}, p1 = {};
    bf16x8 fa[4], fb[4];
#define AT_LDK(dst, g) do { dst[0] = kf(0, 2 * (g)); dst[1] = kf(1, 2 * (g)); dst[2] = kf(0, 2 * (g) + 1); dst[3] = kf(1, 2 * (g) + 1); } while (0)
#define AT_LDV(dst, vb) do { dst[0] = vf(vb, 0); dst[1] = vf(vb, 1); dst[2] = vf(vb, 2); dst[3] = vf(vb, 3); } while (0)
#define AT_QK(src, g) do { p0 = __builtin_amdgcn_mfma_f32_32x32x16_bf16(src[0], qf[2 * (g)], p0, 0, 0, 0); p1 = __builtin_amdgcn_mfma_f32_32x32x16_bf16(src[1], qf[2 * (g)], p1, 0, 0, 0); \
        p0 = __builtin_amdgcn_mfma_f32_32x32x16_bf16(src[2], qf[2 * (g) + 1], p0, 0, 0, 0); p1 = __builtin_amdgcn_mfma_f32_32x32x16_bf16(src[3], qf[2 * (g) + 1], p1, 0, 0, 0); } while (0)
#define AT_SB __builtin_amdgcn_sched_barrier(0)
    AT_LDK(fa, 0); AT_SB;
    AT_LDK(fb, 1); AT_SB; AT_QK(fa, 0); AT_SB;
    AT_LDK(fa, 2); AT_SB; AT_QK(fb, 1); AT_SB;
    AT_LDK(fb, 3); AT_SB; AT_QK(fa, 2); AT_SB;
    AT_LDK(fa, 4); AT_SB; AT_QK(fb, 3); AT_SB;
    AT_LDK(fb, 5); AT_SB; AT_QK(fa, 4); AT_SB;
    AT_LDV(fa, 0); AT_SB; AT_QK(fb, 5); AT_SB;
    if (nvalid < 64) {
#pragma unroll
        for (int r = 0; r < 16; ++r) { if (crow(r, hi) >= nvalid) p0[r] = -INFINITY; if (32 + crow(r, hi) >= nvalid) p1[r] = -INFINITY; }
    }
    float ls = 0.f;
#pragma unroll
    for (int r = 0; r < 16; ++r) { p0[r] = __builtin_amdgcn_exp2f(p0[r]); p1[r] = __builtin_amdgcn_exp2f(p1[r]); ls += p0[r] + p1[r]; }
    l += ls;
    const bf16x8 pa[4] = {pack8(p0, 0), pack8(p0, 8), pack8(p1, 0), pack8(p1, 8)};
#define AT_PV(src, vb) do { _Pragma("unroll") for (int c = 0; c < 4; ++c) o[vb] = __builtin_amdgcn_mfma_f32_32x32x16_bf16(src[c], pa[c], o[vb], 0, 0, 0); } while (0)
    AT_SB;
    AT_LDV(fb, 1); AT_SB; AT_PV(fa, 0); AT_SB;
    AT_LDV(fa, 2); AT_SB; AT_PV(fb, 1); AT_SB;
    AT_LDV(fb, 3); AT_SB; AT_PV(fa, 2); AT_SB;
    AT_PV(fb, 3); AT_SB;
#undef AT_LDK
#undef AT_LDV
#undef AT_QK
#undef AT_PV
#undef AT_SB
}
template <class KF, class VF>
__device__ __forceinline__ void attn_tile_s(const LAS unsigned char* qs, int lane, float& l, f32x16 (&o)[4], const KF& kf, const VF& vf, int nvalid, int hi) {
    f32x16 p0 = {}, p1 = {};
    bf16x8 f[16];
#define AT_SB __builtin_amdgcn_sched_barrier(0)
#pragma unroll
    for (int ks = 0; ks < 8; ++ks) { f[2 * ks] = kf(0, ks); f[2 * ks + 1] = kf(1, ks); }
    AT_SB;
#pragma unroll
    for (int ks = 0; ks < 8; ++ks) { const bf16x8 q = *(const LAS bf16x8*)(qs + ks * 1024 + lane * 16);
        p0 = __builtin_amdgcn_mfma_f32_32x32x16_bf16(f[2 * ks], q, p0, 0, 0, 0); p1 = __builtin_amdgcn_mfma_f32_32x32x16_bf16(f[2 * ks + 1], q, p1, 0, 0, 0); }
    AT_SB;
#pragma unroll
    for (int ks = 0; ks < 4; ++ks) { f[2 * ks] = kf(0, 8 + ks); f[2 * ks + 1] = kf(1, 8 + ks); }
#pragma unroll
    for (int i_ = 0; i_ < 8; ++i_) f[8 + i_] = vf(i_ >> 2, i_ & 3);
    AT_SB;
#pragma unroll
    for (int ks = 0; ks < 4; ++ks) { const bf16x8 q = *(const LAS bf16x8*)(qs + (8 + ks) * 1024 + lane * 16);
        p0 = __builtin_amdgcn_mfma_f32_32x32x16_bf16(f[2 * ks], q, p0, 0, 0, 0); p1 = __builtin_amdgcn_mfma_f32_32x32x16_bf16(f[2 * ks + 1], q, p1, 0, 0, 0); }
    AT_SB;
    bf16x8 g[8];
#pragma unroll
    for (int i_ = 0; i_ < 8; ++i_) g[i_] = vf(2 + (i_ >> 2), i_ & 3);
    AT_SB;
    if (nvalid < 64) {
#pragma unroll
        for (int r = 0; r < 16; ++r) { if (crow(r, hi) >= nvalid) p0[r] = -INFINITY; if (32 + crow(r, hi) >= nvalid) p1[r] = -INFINITY; }
    }
    float ls = 0.f;
#pragma unroll
    for (int r = 0; r < 16; ++r) { p0[r] = __builtin_amdgcn_exp2f(p0[r]); p1[r] = __builtin_amdgcn_exp2f(p1[r]); ls += p0[r] + p1[r]; }
    l += ls;
    const bf16x8 pa[4] = {pack8(p0, 0), pack8(p0, 8), pack8(p1, 0), pack8(p1, 8)};
    AT_SB;
#pragma unroll
    for (int i_ = 0; i_ < 8; ++i_) o[i_ >> 2] = __builtin_amdgcn_mfma_f32_32x32x16_bf16(f[8 + i_], pa[i_ & 3], o[i_ >> 2], 0, 0, 0);
    AT_SB;
#pragma unroll
    for (int i_ = 0; i_ < 8; ++i_) o[2 + (i_ >> 2)] = __builtin_amdgcn_mfma_f32_32x32x16_bf16(g[i_], pa[i_ & 3], o[2 + (i_ >> 2)], 0, 0, 0);
    AT_SB;
#undef AT_SB
}
struct KFLds { const LAS unsigned char* kn; const LAS unsigned char* kp; int l32, hi;
    __device__ __forceinline__ bf16x8 operator()(int p, int ks) const { const int row = 32 * p + l32;
        if (ks < 8) return *(const LAS bf16x8*)(kn + row * 256 + (((2 * ks + hi) ^ (row & 15)) << 4));
        return *(const LAS bf16x8*)(kp + row * 128 + (((2 * (ks - 8) + hi) ^ ((row >> 1) & 7)) << 4)); } };
struct VFLds { const LAS unsigned char* vt; int l32, hi;
    __device__ __forceinline__ bf16x8 operator()(int vb, int c) const { const int row = 32 * vb + l32; return *(const LAS bf16x8*)(vt + row * 128 + (((2 * c + hi) ^ ((row >> 1) & 7)) << 4)); } };
struct KFGlb { const bf16_t* kn; const bf16_t* kp; int hi;
    __device__ __forceinline__ bf16x8 operator()(int p, int ks) const {
        if (ks < 8) return *(const bf16x8*)(kn + (size_t)p * 32 * 2048 + 16 * ks + 8 * hi);
        return *(const bf16x8*)(kp + (size_t)p * 32 * 64 + 16 * (ks - 8) + 8 * hi); } };
struct VFGlb { const bf16_t* vt; int hi;
    __device__ __forceinline__ bf16x8 operator()(int vb, int c) const { return *(const bf16x8*)(vt + (size_t)vb * 32 * VTP + 16 * c + 8 * hi); } };

constexpr int AT_KN = 0, AT_KP = 16384, AT_VT = 24576, AT_BUF = 40960;
__device__ __forceinline__ void attention_phase(const Args& a, LAS unsigned char* lds, int G) {
    int tid_ = threadIdx.x; asm volatile("" : "+v"(tid_)); const int tid = tid_, lane = tid & 63, wave = __builtin_amdgcn_readfirstlane(tid >> 6), l32 = lane & 31, hi = lane >> 5;
    unsigned char* ws = a.ws;
    const bf16_t* QN = (const bf16_t*)(ws + WS_E); const bf16_t* QP = (const bf16_t*)(ws + WS_D);
    const bf16_t* KN = (const bf16_t*)(ws + WS_KN); const bf16_t* KPE = (const bf16_t*)(ws + WS_KPEALL); const bf16_t* VT = (const bf16_t*)(ws + WS_VT);
    bf16_t* ATT = (bf16_t*)(a.out + O_Y) + 2048;
    const int vcu = (G % 8 == 0) ? (blockIdx.x % 8) * (G / 8) + blockIdx.x / 8 : blockIdx.x;
    for (int pr = vcu; pr < 256; pr += G) {
        const int bh = pr >> 3, b = bh >> 4, h = bh & 15;
        for (int half = 0; half < 2; ++half) {
            const int qb = half == 0 ? (pr & 7) : 15 - (pr & 7), q0 = qb * 256, NT = (q0 >> 6) + 4, wch = (q0 >> 6) + (wave >> 1);
            const size_t qrow = (size_t)b * TP + q0 + wave * 32 + l32;
            bf16x8 qf[12];
#pragma unroll
            for (int ks = 0; ks < 8; ++ks) qf[ks] = __builtin_nontemporal_load((const bf16x8*)(QN + qrow * 2048 + h * 128 + 16 * ks + 8 * hi));
#pragma unroll
            for (int ks = 0; ks < 4; ++ks) qf[8 + ks] = __builtin_nontemporal_load((const bf16x8*)(QP + qrow * 1024 + h * 64 + 16 * ks + 8 * hi));
            float l = 0.f; f32x16 o[4] = {};
            const size_t kv0 = (size_t)b * TP;
#define AT_DMA(j, buf) do { const size_t kr = kv0 + 64 * (size_t)(j); LAS unsigned char* bb = lds + (buf) * AT_BUF; \
                _Pragma("unroll") for (int i = 0; i < 2; ++i) { const int rg = 2 * wave + i; \
                    { const int row = 4 * rg + (lq >> 4), ch = (lq & 15) ^ (row & 15); \
                      __builtin_amdgcn_global_load_lds((const unsigned*)(KN + (kr + row) * 2048 + h * 128 + 8 * ch), (LAS unsigned*)(bb + AT_KN + rg * 1024), 16, 0, 0); } \
                    { const int row = 8 * rg + (lq >> 3), ch = (lq & 7) ^ ((row >> 1) & 7); \
                      __builtin_amdgcn_global_load_lds((const unsigned*)(VT + (size_t)(h * 128 + row) * VTP + kr + 8 * ch), (LAS unsigned*)(bb + AT_VT + rg * 1024), 16, 0, 0); } } \
                { const int row = 8 * wave + (lq >> 3), ch = (lq & 7) ^ ((row >> 1) & 7); \
                  __builtin_amdgcn_global_load_lds((const unsigned*)(KPE + (kr + row) * 64 + 8 * ch), (LAS unsigned*)(bb + AT_KP + wave * 1024), 16, 0, 0); } } while (0)
            int lq = lane; asm volatile("" : "+v"(lq));
            AT_DMA(0, 0); AT_DMA(1, 1);
            int slot = 0;
            for (int j = 0; j < NT; ++j) {
                if (j + 1 < NT) asm volatile("s_waitcnt vmcnt(5)" ::: "memory"); else asm volatile("s_waitcnt vmcnt(0)" ::: "memory");
                __builtin_amdgcn_s_barrier(); asm volatile("" ::: "memory");
                lq = lane; asm volatile("" : "+v"(lq));
                { const int s2 = slot >= 1 ? slot - 1 : 2;
                  if (j + 2 < NT) AT_DMA(j + 2, s2); }
                if (j <= wch) {
                    const LAS unsigned char* bb = lds + slot * AT_BUF;
                    const KFLds kf{bb + AT_KN, bb + AT_KP, l32, hi}; const VFLds vf{bb + AT_VT, l32, hi};
                    attn_tile(qf, l, o, kf, vf, 64, hi);
                }
                slot = slot == 2 ? 0 : slot + 1;
                asm volatile("s_waitcnt lgkmcnt(0)" ::: "memory");
            }
            __syncthreads();
            l += __shfl_xor(l, 32); const float inv = 1.0f / l;
            bf16_t* op = ATT + qrow * 4096 + h * 128;
#pragma unroll
            for (int vb = 0; vb < 4; ++vb)
#pragma unroll
                for (int q4 = 0; q4 < 4; ++q4) { u32x2 w; w.x = pk2(o[vb][4 * q4] * inv, o[vb][4 * q4 + 1] * inv); w.y = pk2(o[vb][4 * q4 + 2] * inv, o[vb][4 * q4 + 3] * inv);
                    *(u32x2*)(op + 32 * vb + 8 * q4 + 4 * hi) = w; }
        }
    }
#undef AT_DMA
    for (int it = blockIdx.x; it < 256; it += G) {
        const int db = it >> 4, h = it & 15; const size_t kv0 = (size_t)MP + db * KSS;
        const size_t qrow = (size_t)MP + db * 16 + (l32 & 15);
        const LAS unsigned char* qs = lds + 66560;
        if (wave == 0) { const bf16x8 z8 = {0, 0, 0, 0, 0, 0, 0, 0};
#pragma unroll
            for (int ks = 0; ks < 8; ++ks) *(LAS bf16x8*)(lds + 66560 + ks * 1024 + lane * 16) = l32 < 16 ? *(const bf16x8*)(QN + qrow * 2048 + h * 128 + 16 * ks + 8 * hi) : z8;
#pragma unroll
            for (int ks = 0; ks < 4; ++ks) *(LAS bf16x8*)(lds + 66560 + (8 + ks) * 1024 + lane * 16) = l32 < 16 ? *(const bf16x8*)(QP + qrow * 1024 + h * 64 + 16 * ks + 8 * hi) : z8; }
        __syncthreads();
        float l = 0.f; f32x16 o[4] = {};
        for (int j = wave; j < 17; j += 8) {
            const size_t kr = kv0 + 64 * (size_t)j;
            const KFGlb kf{KN + (kr + l32) * 2048 + h * 128, KPE + (kr + l32) * 64, hi}; const VFGlb vf{VT + (size_t)(h * 128 + l32) * VTP + kr, hi};
            attn_tile_s(qs, lane, l, o, kf, vf, KSS - 64 * j, hi);
        }
        l += __shfl_xor(l, 32);
        LAS float* Mw = (LAS float*)lds; LAS float* Lw = Mw + 128; LAS float* Ow = Mw + 256;
        if (l32 < 16) { if (hi == 0) { Lw[wave * 16 + l32] = l; }
#pragma unroll
            for (int vb = 0; vb < 4; ++vb)
#pragma unroll
                for (int q4 = 0; q4 < 4; ++q4) *(LAS f32x4*)(Ow + (wave * 16 + l32) * 128 + 32 * vb + 8 * q4 + 4 * hi) = (f32x4){o[vb][4 * q4], o[vb][4 * q4 + 1], o[vb][4 * q4 + 2], o[vb][4 * q4 + 3]}; }
        __syncthreads();
        { const int q = tid >> 5, v4 = (tid & 31) * 4;
          float L = 0.f; f32x4 O = {0.f, 0.f, 0.f, 0.f};
#pragma unroll
          for (int w = 0; w < 8; ++w) { L += Lw[w * 16 + q]; O += *(const LAS f32x4*)(Ow + (w * 16 + q) * 128 + v4); }
          const float inv = 1.0f / L; u32x2 wv; wv.x = pk2(O[0] * inv, O[1] * inv); wv.y = pk2(O[2] * inv, O[3] * inv);
          *(u32x2*)(ATT + ((size_t)MP + db * 16 + q) * 4096 + h * 128 + v4) = wv; }
        __syncthreads();
    }
}
typedef float f32x2 __attribute__((ext_vector_type(2)));
__device__ __forceinline__ f32x2 gelu_pk(f32x2 v) {
    const f32x2 av = __builtin_elementwise_abs(v), d = av * 0.2316418882f + 1.0f;
    f32x2 t; t.x = __builtin_amdgcn_rcpf(d.x); t.y = __builtin_amdgcn_rcpf(d.y);
    f32x2 q = t * 0.5307027145f + (-0.7265760135f); q = q * t + 0.7107068705f; q = q * t + (-0.142248368f); q = q * t + 0.127414796f; q = q * t;
    const f32x2 s = (v * v) * (-0.72134752044f);
    f32x2 e; e.x = __builtin_amdgcn_exp2f(s.x); e.y = __builtin_amdgcn_exp2f(s.y);
    const f32x2 m = v * (q * e), r = v - m;
    f32x2 o; o.x = v.x < 0.f ? m.x : r.x; o.y = v.y < 0.f ? m.y : r.y; return o;
}
#define RLX_AGENT __ATOMIC_RELAXED, __HIP_MEMORY_SCOPE_AGENT
#define XB_TMO      128
#define XB_XCNT(j)  (256  + 64 * (j))
#define XB_XSUB(j)  (1280 + 64 * (j))
#define XB_XGEN(j)  (2304 + 64 * (j))
#define XB_TOP      3328
#define XB_TOPGEN   3392
#define XCD_BAR_WORDS 3456
#define XB_SPIN_CAP (1u << 18)

__device__ __forceinline__ unsigned xb_ld(unsigned* p)              { return __hip_atomic_load(p, __ATOMIC_RELAXED, __HIP_MEMORY_SCOPE_AGENT); }
__device__ __forceinline__ unsigned xb_add(unsigned* p, unsigned v) { return __hip_atomic_fetch_add(p, v, __ATOMIC_RELAXED, __HIP_MEMORY_SCOPE_AGENT); }
__device__ __forceinline__ unsigned xb_xcc_id() { return (unsigned)__builtin_amdgcn_s_getreg((3 << 11) | 20) & 0xFu; }
#define XB_SPIN(cond, bar) do { unsigned _sp = 0; while (cond) { __builtin_amdgcn_s_sleep(1); \
    if ((++_sp & 255u) == 0u) { if (xb_ld(&(bar)[XB_TMO])) break; if (_sp > XB_SPIN_CAP) { atomicAdd(&(bar)[XB_TMO], 1u); break; } } } } while (0)

struct XcdBarrier {
    unsigned* bar; unsigned x;
    volatile LAS unsigned* st;
};

__device__ __forceinline__ XcdBarrier xcd_barrier_post(unsigned* bar, volatile LAS unsigned* st) {
    XcdBarrier b; b.bar = bar; b.x = xb_xcc_id(); b.st = st;
    if (threadIdx.x == 0) (void)xb_add(&bar[XB_XCNT(b.x)], 1u);
    return b;
}
__device__ __forceinline__ void xcd_barrier_complete(unsigned* bar, unsigned x, unsigned& nloc, unsigned& nx) {
    const unsigned G = gridDim.x * gridDim.y * gridDim.z;
    unsigned sum, cnt, mine, sp = 0u;
    for (;;) {
        sum = 0u; cnt = 0u; mine = 0u;
#pragma unroll
        for (unsigned j = 0; j < 16; ++j) { const unsigned c = xb_ld(&bar[XB_XCNT(j)]); sum += c; cnt += (c > 0u) ? 1u : 0u; mine = (j == x) ? c : mine; }
        if (sum == G) break;
        __builtin_amdgcn_s_sleep(1);
        if ((++sp & 255u) == 0u) { if (xb_ld(&bar[XB_TMO])) break; if (sp > XB_SPIN_CAP) { atomicAdd(&bar[XB_TMO], 1u); break; } }
    }
    nloc = mine > 0u ? mine : 1u; nx = cnt > 0u ? cnt : 1u;
}

__device__ __forceinline__ void xcd_barrier(const XcdBarrier& b) {
    asm volatile("s_waitcnt vmcnt(0)" ::: "memory");
    __syncthreads();
    if (threadIdx.x == 0) {
        unsigned* bar = b.bar;
        __builtin_amdgcn_s_waitcnt(0);
        unsigned nloc = b.st[0], nx = b.st[1];
        if (nloc == 0u) { xcd_barrier_complete(bar, b.x, nloc, nx); b.st[0] = nloc; b.st[1] = nx; }
        const unsigned old = xb_add(&bar[XB_XSUB(b.x)], 1u);
        const unsigned gen = old / nloc;
        if (old + 1u == (gen + 1u) * nloc) {
            __builtin_amdgcn_fence(__ATOMIC_RELEASE, "agent");
            asm volatile("s_waitcnt vmcnt(0)" ::: "memory");
            const unsigned og = xb_add(&bar[XB_TOP], 1u);
            const unsigned tg = og / nx;
            if (og + 1u == (tg + 1u) * nx) xb_add(&bar[XB_TOPGEN], 1u);
            else XB_SPIN(xb_ld(&bar[XB_TOPGEN]) == tg, bar);
            __builtin_amdgcn_fence(__ATOMIC_ACQUIRE, "agent");
            xb_add(&bar[XB_XGEN(b.x)], 1u);
            asm volatile("s_waitcnt vmcnt(0)" ::: "memory");
        } else {
            XB_SPIN(xb_ld(&bar[XB_XGEN(b.x)]) == gen, bar);
            __builtin_amdgcn_fence(__ATOMIC_ACQUIRE, "agent");
            asm volatile("s_waitcnt vmcnt(0)" ::: "memory");
        }
    }
    __syncthreads();
}

#ifndef PH_MAX
#define PH_MAX 99
#endif
typedef const __attribute__((address_space(4))) Args* KArgP;
#define PH_BEGIN { KArgP ap_ = kap; asm volatile("" : "+s"(ap_)); const Args a = *ap_; unsigned char* ws = a.ws; \
    int tid_ = threadIdx.x; asm volatile("" : "+v"(tid_)); const int tid = tid_, lane = tid & 63, wave = __builtin_amdgcn_readfirstlane(tid >> 6), gw = bid * 8 + wave, NGW = G * 8; \
    LAS float* scr = (LAS float*)(lds + wave * 16384); LAS float* xs = (LAS float*)(lds + XS_OFF); const float* RT = (const float*)(ws + WS_ROPE); \
    (void)tid; (void)lane; (void)gw; (void)NGW; (void)scr; (void)xs; (void)RT;
#define PH_END }
__global__ void __launch_bounds__(512, 2) mega(Args a_unused) {
#if defined(__HIP_DEVICE_COMPILE__)
    extern __shared__ __attribute__((aligned(16))) unsigned char lds_raw[];
    LAS unsigned char* lds = (LAS unsigned char*)lds_raw;
    cg::grid_group grid = cg::this_grid();
    const int G = gridDim.x, bid = blockIdx.x;
    const KArgP kap = (KArgP)__builtin_amdgcn_kernarg_segment_ptr();
    volatile LAS unsigned* bst = (volatile LAS unsigned*)(lds + LDS_BYTES - 64);
    if (threadIdx.x < 2) bst[threadIdx.x] = 0u;
    __syncthreads();

    if (G == 0x7fffffff) grid.sync();
    XcdBarrier xbar;
    { KArgP ap_ = kap; asm volatile("" : "+s"(ap_)); xbar = xcd_barrier_post((unsigned*)(ap_->ws + WS_CTR), bst); }
    PH_BEGIN phase0(a, lds, G); PH_END
    xcd_barrier(xbar);
    PH_BEGIN {
        pg8::Gemm g{(const bf16_t*)(ws + WS_E), (const bf16_t*)(ws + WS_D), MA, NIN, 2048, 2048, 2048};
        pg8::StaticOrder S; S.init(MA, NIN, G, bid); EpiZ E{ws};
        pg8::gemm_phase<EpiZ, pg8::StaticOrder, true, true>(lds, g, S, E);
    } PH_END
    xcd_barrier(xbar);
    PH_BEGIN phase2(a, lds, G); PH_END
    xcd_barrier(xbar);
    PH_BEGIN {
        const int nscan = G / 2;
        if (bid >= nscan) {
            pg8::Gemm g{(const bf16_t*)(ws + WS_ZMQ), (const bf16_t*)(ws + WS_WUQ), MA, 3072, 512, 512, 512};
            pg8::StaticOrder S; S.init(MA, 3072, G - nscan, bid - nscan);
            EpiHead E{(bf16_t*)(ws + WS_E), 2048, a.in[16], 8, (bf16_t*)(ws + WS_D), 1024, a.in[18], RT, xs, ATT_C};
            pg8::gemm_phase<EpiHead, pg8::StaticOrder, true, true>(lds, g, S, E);
        }
    } PH_END
    PH_BEGIN { __syncthreads(); const int nscan = G / 2; gla_phase(a, lds, bid < nscan ? bid : 128, nscan); } PH_END
    xcd_barrier(xbar);
    PH_BEGIN {
        {
            pg8::Gemm g{(const bf16_t*)(ws + WS_CKVALL), (const bf16_t*)(ws + WS_WUKV), MKV, 2048, 512, 512, 512};
            pg8::StaticOrder S; S.init(MKV, 2048, G, bid);
            EpiHead E{(bf16_t*)(ws + WS_KN), 2048, a.in[17], 8, nullptr, 0, nullptr, RT, xs, 1.0f};
            pg8::gemm_phase<EpiHead, pg8::StaticOrder, true, true>(lds, g, S, E);
        }
        {
            pg8::Gemm g{(const bf16_t*)(ws + WS_WUKV) + (size_t)2048 * 512, (const bf16_t*)(ws + WS_CKVALL), 2048, MKV, 512, 512, 512};
            pg8::StaticOrder S; S.init(2048, MKV, G, (bid + G - 8) % G);
            EpiVT E{(bf16_t*)(ws + WS_VT)};
            pg8::gemm_phase<EpiVT, pg8::StaticOrder, true, true>(lds, g, S, E);
        }
        gla_norm(a, G);
    } PH_END
    xcd_barrier(xbar);
    PH_BEGIN {
        attention_phase(a, lds, G);
        __syncthreads();
    } PH_END
    PH_BEGIN {
        transpose_matrix_q(a.in[11], 2048, 2048, 2048, (bf16_t*)(ws + WS_WBR), 4096, 0, nullptr, ScId(), gw, NGW, lane);
        transpose_matrix_q(a.in[20], 2048, 2048, 2048, (bf16_t*)(ws + WS_WBR), 4096, 2048, nullptr, ScId(), gw, NGW, lane);
        transpose_matrix_q(a.in[21], 2048, 2048, 2048, (bf16_t*)(ws + WS_WOUT), 2048, 0, nullptr, ScId(), gw, NGW, lane);
    } PH_END
    xcd_barrier(xbar);
    PH_BEGIN {
        pg8::Gemm g{(const bf16_t*)(a.out + O_Y), (const bf16_t*)(ws + WS_WBR), MP, 2048, 4096, 4096, 4096};
        pg8::StaticOrder S; S.init(MP, 2048, G, bid);
        EpiMerge E{(const bf16_t*)(ws + WS_ZGA), (const bf16_t*)(ws + WS_ZGB), (bf16_t*)(ws + WS_MB)};
        pg8::gemm_phase<EpiMerge, pg8::StaticOrder, true, true>(lds, g, S, E);
    } PH_END
    PH_BEGIN {
        int ksz = 256; asm volatile("" : "+s"(ksz));
        pg8::Gemm g{(const bf16_t*)(a.out + O_Y), (const bf16_t*)(ws + WS_WBR), MA, 2048, ksz, 4096, 4096};
        pg8::SplitOrder S{MP / 256, 8, 16, 256, G, bid};
        EpiPart E{(float*)(ws + WS_TA)};
        pg8::gemm_phase<EpiPart, pg8::SplitOrder, true, true>(lds, g, S, E);
    } PH_END
    xcd_barrier(xbar);
    PH_BEGIN {
        const float* P = (const float*)(ws + WS_TA); const bf16_t* GA = (const bf16_t*)(ws + WS_ZGA) + (size_t)MP * DM; const bf16_t* GB = (const bf16_t*)(ws + WS_ZGB) + (size_t)MP * DM;
        bf16_t* MBs = (bf16_t*)(ws + WS_MB) + (size_t)MP * DM;
        for (int i = bid * 512 + tid; i < 256 * DM / 4; i += G * 512) { f32x4 sa = {0.f, 0.f, 0.f, 0.f}, sb = sa;
#pragma unroll
            for (int k = 0; k < 8; ++k) { sa += __builtin_nontemporal_load((const f32x4*)(P + (size_t)k * 256 * DM + 4 * (size_t)i)); sb += __builtin_nontemporal_load((const f32x4*)(P + (size_t)(8 + k) * 256 * DM + 4 * (size_t)i)); }
            const u32x2 ga = *(const u32x2*)(GA + 4 * (size_t)i), gb = *(const u32x2*)(GB + 4 * (size_t)i);
            u32x2 o; o.x = pk2(sa[0] * sigmoidf_(bflo(ga.x)) + sb[0] * sigmoidf_(bflo(gb.x)), sa[1] * sigmoidf_(bfhi(ga.x)) + sb[1] * sigmoidf_(bfhi(gb.x)));
            o.y = pk2(sa[2] * sigmoidf_(bflo(ga.y)) + sb[2] * sigmoidf_(bflo(gb.y)), sa[3] * sigmoidf_(bfhi(ga.y)) + sb[3] * sigmoidf_(bfhi(gb.y)));
            *(u32x2*)(MBs + 4 * (size_t)i) = o; }
    } PH_END
    xcd_barrier(xbar);
    PH_BEGIN {
        pg8::Gemm g{(const bf16_t*)(ws + WS_MB), (const bf16_t*)(ws + WS_WOUT), MP, 2048, 2048, 2048, 2048};
        pg8::StaticOrder S; S.init(MP, 2048, G, bid);
        EpiX1 E{a.in[0], a.in[1], a.out + O_Y, (bf16_t*)(ws + WS_E), (float*)(ws + WS_SUMSQ)};
        pg8::gemm_phase<EpiX1, pg8::StaticOrder, true, true>(lds, g, S, E);
    } PH_END
    PH_BEGIN {
        int ksz = 256; asm volatile("" : "+s"(ksz));
        pg8::Gemm g{(const bf16_t*)(ws + WS_MB), (const bf16_t*)(ws + WS_WOUT), MA, 2048, ksz, 2048, 2048};
        pg8::SplitOrder S{MP / 256, 8, 8, 256, G, bid};
        EpiPart E{(float*)(ws + WS_TA) + (size_t)16 * 256 * DM};
        pg8::gemm_phase<EpiPart, pg8::SplitOrder, true, true>(lds, g, S, E);
        __syncthreads();
        transpose_matrix_q(a.in[23], 2048, 2 * DFF, 2 * DFF, (bf16_t*)(ws + WS_WUP), 2048, 0, a.in[22], ScUp(), gw, NGW, lane);
    } PH_END
    xcd_barrier(xbar);
    PH_BEGIN {
        const float* P = (const float*)(ws + WS_TA) + (size_t)16 * 256 * DM; float* SS = (float*)(ws + WS_SUMSQ); bf16_t* X1B = (bf16_t*)(ws + WS_E);
        for (int r = gw; r < 256; r += NGW) { float ss = 0.f;
#pragma unroll
            for (int j = 0; j < 8; ++j) { const size_t o = (size_t)r * DM + 4 * lane + 256 * j; f32x4 v = *(const f32x4*)(a.in[1] + o);
#pragma unroll
                for (int k = 0; k < 8; ++k) v += __builtin_nontemporal_load((const f32x4*)(P + (size_t)k * 256 * DM + o));
                *(f32x4*)(a.out + O_Y + (size_t)MP * DM + o) = v;
                u32x2 w; w.x = pk2(v[0], v[1]); w.y = pk2(v[2], v[3]); *(u32x2*)(X1B + (size_t)MP * DM + o) = w;
                ss += (v[0] * v[0] + v[1] * v[1]) + (v[2] * v[2] + v[3] * v[3]); }
            ss = wave_sum(ss); if (lane == 0) SS[MP + r] = ss; }
    } PH_END
    xcd_barrier(xbar);
    PH_BEGIN {
        pg8::Gemm g{(const bf16_t*)(ws + WS_E), (const bf16_t*)(ws + WS_WUP), MA, 2 * DFF, 2048, 2048, 2048};
        pg8::StaticOrder S; S.init(MA, 2 * DFF, G, bid);
        EpiUpG E{(bf16_t*)(ws + WS_G), (const float*)(ws + WS_SUMSQ), a.out, a.in[24], a.in[25], a.in[5], (float*)(ws + WS_SIDE)};
        pg8::gemm_phase<EpiUpG, pg8::StaticOrder, true, true>(lds, g, S, E);
    } PH_END
    PH_BEGIN {
        const int rem = ((MA / 256) * (2 * DFF / 256)) % G, first = rem, nearly = G - rem;
        if (bid >= first) { const int nblk = 2048 / 32, nit = (DFF / 64) * nblk;
            for (int it = (bid - first) * 8 + wave; it < nit; it += nearly * 8) transpose_item_q(a.in[26], 2048, (bf16_t*)(ws + WS_WDOWN), DFF, 0, it / nblk, it % nblk, lane, nullptr, ScId()); }
    } PH_END
    xcd_barrier(xbar);
    PH_BEGIN {
        const float* AH = (const float*)(ws + WS_SIDE); const float* AF0 = AH + 33 * 8 * DFF; const float* GT0 = AH + 2 * 33 * 8 * DFF;
        const float* cw = a.in[24]; const float* cb = a.in[25]; bf16_t* Gb = (bf16_t*)(ws + WS_G);
        for (int i = bid * 512 + tid; i < 32 * 8 * DFF; i += G * 512) { const int c = i % DFF, q = i / DFF, rr = q & 1, pb = q >> 1, pm = pb >> 2, blk = pb & 3;
            const float a0 = AF0[((size_t)pb * 2 + rr) * DFF + c], gt = GT0[((size_t)pb * 2 + rr) * DFF + c];
            const bool start = blk == 0 && (pm == 0 || pm == TP / 256);
            const float h1 = start ? 0.f : AH[((size_t)(pb - 1) * 2 + 1) * DFF + c], h0 = start ? 0.f : AH[((size_t)(pb - 1) * 2) * DFF + c];
            const float a1 = rr == 0 ? h1 : AF0[((size_t)pb * 2) * DFF + c];
            const float a2 = rr == 0 ? h0 : h1;
            const float cv = cb[c] + cw[2 * DFF + c] * a0 + cw[DFF + c] * a1 + cw[c] * a2;
            f32x2 v2; v2.x = cv; v2.y = 0.f; const f32x2 ge = gelu_pk(v2);
            Gb[(size_t)(pm * 256 + blk * 64 + rr) * DFF + c] = (bf16_t)(pk2(ge.x * gt, 0.f) & 0xffffu); }
    } PH_END
    PH_BEGIN {
        int ksz = 256; asm volatile("" : "+s"(ksz));
        pg8::Gemm g{(const bf16_t*)(ws + WS_G), (const bf16_t*)(ws + WS_WDOWN), MA, 2048, ksz, DFF, DFF};
        pg8::SplitOrder S{MP / 256, 8, DFF / 256, 256, G, bid};
        EpiPart E{(float*)(ws + WS_PART)};
        __syncthreads();
        pg8::gemm_phase<EpiPart, pg8::SplitOrder, true, true>(lds, g, S, E);
    } PH_END
    xcd_barrier(xbar);
    PH_BEGIN {
        {
            const float* P = (const float*)(ws + WS_PART); float* Y = a.out + O_Y + (size_t)MP * DM;
            for (int i = bid * 512 + tid; i < 256 * DM / 4; i += G * 512) { f32x4 s = *(const f32x4*)(Y + 4 * (size_t)i);
#pragma unroll
                for (int k = 0; k < DFF / 256; ++k) s += __builtin_nontemporal_load((const f32x4*)(P + (size_t)k * 256 * DM + 4 * (size_t)i));
                *(f32x4*)(Y + 4 * (size_t)i) = s; }
        }
        {
            pg8::Gemm g{(const bf16_t*)(ws + WS_G), (const bf16_t*)(ws + WS_WDOWN), MP, 2048, DFF, DFF, DFF};
            pg8::StaticOrder S; S.init(MP, 2048, G, bid);
            EpiY E{a.out + O_Y};
            pg8::gemm_phase<EpiY, pg8::StaticOrder, true, true>(lds, g, S, E);
        }
    } PH_END
#endif
}

extern "C" void kernel_launch(void* const* d_in, const int* in_sizes, int n_in, void* d_out, int out_size, void* d_ws, size_t ws_size, hipStream_t stream) {
    static int grid = 0;
    if (grid == 0) {
        if (n_in != 27 || ws_size < WS_END || out_size != (int)O_END) { fprintf(stderr, "kernel_launch: unexpected problem: n_in %d ws %zu out %d\n", n_in, ws_size, out_size); grid = -1; return; }
        int dev = 0, cus = 0, per_cu = 0;
        (void)hipGetDevice(&dev); (void)hipDeviceGetAttribute(&cus, hipDeviceAttributeMultiprocessorCount, dev);
        (void)hipFuncSetAttribute((const void*)mega, hipFuncAttributeMaxDynamicSharedMemorySize, LDS_BYTES);
        (void)hipOccupancyMaxActiveBlocksPerMultiprocessor(&per_cu, (const void*)mega, 512, LDS_BYTES);
        if (per_cu < 1) { fprintf(stderr, "kernel_launch: occupancy query says %d blocks/CU\n", per_cu); grid = -1; return; }
        grid = cus;
    }
    if (grid < 0) return;
    if (hipMemsetAsync((unsigned char*)d_ws + WS_CTR, 0, 16384, stream) != hipSuccess) { fprintf(stderr, "kernel_launch: memset of the barrier words failed\n"); return; }
    Args a{};
    for (int i = 0; i < 27; ++i) a.in[i] = (const float*)d_in[i];
    a.out = (float*)d_out; a.ws = (unsigned char*)d_ws;
    void* args[] = {&a};
    hipError_t e = hipLaunchCooperativeKernel((const void*)mega, dim3(grid), dim3(512), args, LDS_BYTES, stream);
    if (e != hipSuccess) fprintf(stderr, "cooperative launch failed: %s (grid %d)\n", hipGetErrorString(e), grid);
}
```
